# Optimizing an MI355X kernel written in HIP

```python
import math
import jax, jax.numpy as jnp
from jax import lax
import numpy as np

D_MODEL = 1024
BATCH = 8
SEQ = 4096
DEPTH = 2
DEC_BATCH = 8
DEC_SEQ = 64
PAST_LEN = 1024

CHUNK = 64
N_META = 16
Q_BLOCK = 128
EPS = 1e-6
D_FF = 2816
GDN_HEADS = 4
GDN_DK = 128
GDN_DV = 128
GDN_CONV = 4
MLA_HEADS = 8
MLA_NOPE = 64
MLA_ROPE = 32
MLA_V = 64
MLA_Q_RANK = 384
MLA_KV_RANK = 256
ROPE_THETA = 10000.0
SC_WIDTH = 3

N_A_LAYERS = (DEPTH + 1) // 2
N_C_LAYERS = DEPTH // 2
GDN_QKV = GDN_HEADS * (2 * GDN_DK + GDN_DV)
GDN_COLS = GDN_QKV + GDN_HEADS * GDN_DV + 2 * GDN_HEADS
MLA_COLS = MLA_Q_RANK + MLA_KV_RANK + MLA_ROPE
IN_COLS = GDN_COLS + MLA_COLS
MIX_WIDTH = GDN_HEADS * GDN_DV + MLA_HEADS * MLA_V
BIG_CHUNK_ID = 1 << 30

kernel_name = 'hybrid_streaming_gdn_mla_shortconv_step'


def rms_norm(x, g):
    xf = x.astype(jnp.float32)
    y = xf * lax.rsqrt(jnp.mean(xf * xf, -1, keepdims=True) + EPS)
    return (y * g.astype(jnp.float32)).astype(x.dtype)


def l2norm(x):
    xf = x.astype(jnp.float32)
    return xf * lax.rsqrt(jnp.sum(xf * xf, -1, keepdims=True) + EPS)


def half_ffn(x, g, w_gate, w_up, w_down):
    h = rms_norm(x, g)
    return x + 0.5 * ((jax.nn.silu(h @ w_gate) * (h @ w_up)) @ w_down)


def causal_dwconv(x, w, prev):
    width = w.shape[0]
    t = x.shape[1]
    xp = jnp.concatenate([prev, x], 1)
    y = sum(xp[:, i:i + t] * w[i] for i in range(width))
    return y, xp[:, xp.shape[1] - (width - 1):]


def rope(x, pos):
    half = x.shape[-1] // 2
    inv = ROPE_THETA ** (-jnp.arange(half, dtype=jnp.float32) / half)
    ang = pos.astype(jnp.float32)[:, None] * inv
    shape = (pos.shape[0],) + (1,) * (x.ndim - 3) + (half,)
    cos, sin = jnp.cos(ang).reshape(shape), jnp.sin(ang).reshape(shape)
    xf = x.astype(jnp.float32)
    x1, x2 = xf[..., :half], xf[..., half:]
    return jnp.concatenate([x1 * cos - x2 * sin, x2 * cos + x1 * sin], -1).astype(x.dtype)


def gated_delta_chunked(q, k, v, g, beta, S0):
    b, T, H, dk = q.shape
    dv = v.shape[-1]
    n = T // CHUNK
    blk = lambda a: a.reshape((b, n, CHUNK) + a.shape[2:])
    to_h = lambda a: jnp.moveaxis(a, 3, 2)
    qh, kh, vh = to_h(blk(q)), to_h(blk(k)), to_h(blk(v))
    bh = to_h(blk(beta))
    Gh = jnp.cumsum(to_h(blk(g)), axis=-1)
    dG = Gh[..., :, None] - Gh[..., None, :]
    idx = jnp.arange(CHUNK)
    dec_strict = jnp.exp(jnp.where(idx[:, None] > idx[None, :], dG, -jnp.inf))
    dec_causal = jnp.exp(jnp.where(idx[:, None] >= idx[None, :], dG, -jnp.inf))
    kk = jnp.einsum('bnhid,bnhjd->bnhij', kh, kh)
    A = jnp.eye(CHUNK, dtype=jnp.float32) + bh[..., :, None] * kk * dec_strict
    rhs = jnp.concatenate([bh[..., None] * vh, (bh * jnp.exp(Gh))[..., None] * kh], -1)
    sol = lax.linalg.triangular_solve(A, rhs, left_side=True, lower=True)
    U, Wk = sol[..., :dv], sol[..., dv:]
    qk = jnp.einsum('bnhid,bnhjd->bnhij', qh, kh) * dec_causal
    qd = qh * jnp.exp(Gh)[..., None]
    g_last = Gh[..., -1]
    kt = kh * jnp.exp(g_last[..., None] - Gh)[..., None]

    def step(S, xs):
        qk_c, qd_c, U_c, Wk_c, kt_c, gl_c = xs
        W = U_c - jnp.einsum('bhcd,bhde->bhce', Wk_c, S)
        o = jnp.einsum('bhcd,bhde->bhce', qd_c, S) + jnp.einsum('bhij,bhje->bhie', qk_c, W)
        S = S * jnp.exp(gl_c)[..., None, None] + jnp.einsum('bhcd,bhce->bhde', kt_c, W)
        return S, o

    front = lambda a: jnp.moveaxis(a, 1, 0)
    S, o = lax.scan(step, S0, (front(qk), front(qd), front(U), front(Wk), front(kt), front(g_last)))
    o = jnp.transpose(o, (1, 0, 3, 2, 4)).reshape(b, T, H, dv)
    return o, S


def gdn_mixer(h, S0, conv_prev, conv_w, A_log, dt_bias, o_norm):
    b, t, _ = h.shape
    s1 = GDN_QKV + GDN_HEADS * GDN_DV
    qkv, z, a, bt = jnp.split(h, [GDN_QKV, s1, s1 + GDN_HEADS], axis=-1)
    qkv, conv_new = causal_dwconv(qkv, conv_w, conv_prev)
    qkv = jax.nn.silu(qkv)
    q, k, v = jnp.split(qkv, [GDN_HEADS * GDN_DK, 2 * GDN_HEADS * GDN_DK], axis=-1)
    q = l2norm(q.reshape(b, t, GDN_HEADS, GDN_DK)) * (GDN_DK ** -0.5)
    k = l2norm(k.reshape(b, t, GDN_HEADS, GDN_DK))
    v = v.reshape(b, t, GDN_HEADS, GDN_DV).astype(jnp.float32)
    g = -jnp.exp(A_log.astype(jnp.float32)) * jax.nn.softplus(a.astype(jnp.float32) + dt_bias.astype(jnp.float32))
    beta = jax.nn.sigmoid(bt.astype(jnp.float32))
    pad = (-t) % CHUNK
    padt = lambda u: jnp.pad(u, [(0, 0), (0, pad)] + [(0, 0)] * (u.ndim - 2))
    o, S = gated_delta_chunked(padt(q), padt(k), padt(v), padt(g), padt(beta), S0.astype(jnp.float32))
    o = rms_norm(o[:, :t], o_norm) * jax.nn.silu(z.reshape(b, t, GDN_HEADS, GDN_DV).astype(jnp.float32))
    return o.reshape(b, t, GDN_HEADS * GDN_DV).astype(h.dtype), S.astype(S0.dtype), conv_new


def attn_probs_v(qn, qr, kn, kr, v, mask):
    s = jnp.einsum('bqhd,bkhd->bhqk', qn, kn) + jnp.einsum('bqhd,bkd->bhqk', qr, kr)
    s = s.astype(jnp.float32) * ((MLA_NOPE + MLA_ROPE) ** -0.5)
    if mask is not None:
        s = jnp.where(mask, s, -jnp.inf)
    p = jax.nn.softmax(s, axis=-1).astype(v.dtype)
    return jnp.einsum('bhqk,bkhd->bqhd', p, v)


def mla_mixer(h, pos, cache_ckv, cache_kr, q_norm, w_uq, kv_norm, w_ukv, qn_norm, qr_norm, kn_norm, kr_norm):
    b, t, _ = h.shape
    cq, ckv, kr = jnp.split(h, [MLA_Q_RANK, MLA_Q_RANK + MLA_KV_RANK], axis=-1)
    q = (rms_norm(cq, q_norm) @ w_uq).reshape(b, t, MLA_HEADS, MLA_NOPE + MLA_ROPE)
    q_nope = rms_norm(q[..., :MLA_NOPE], qn_norm)
    q_rope = rope(rms_norm(q[..., MLA_NOPE:], qr_norm), pos)
    ckv_new = rms_norm(ckv, kv_norm)
    kr_new = rope(rms_norm(kr, kr_norm), pos)
    if cache_ckv is None:
        ckv_all, kr_all = ckv_new, kr_new
    else:
        ckv_all = jnp.concatenate([cache_ckv, ckv_new], 1)
        kr_all = jnp.concatenate([cache_kr, kr_new], 1)
    kv = (ckv_all @ w_ukv).reshape(b, ckv_all.shape[1], MLA_HEADS, MLA_NOPE + MLA_V)
    k_nope = rms_norm(kv[..., :MLA_NOPE], kn_norm)
    v = kv[..., MLA_NOPE:]
    if cache_ckv is None:
        L = t
        cid = (jnp.arange(L) - N_META) // CHUNK
        nb = -(-L // Q_BLOCK)
        pad = nb * Q_BLOCK - L
        qblk = lambda a: jnp.moveaxis(jnp.pad(a, [(0, 0), (0, pad), (0, 0), (0, 0)]).reshape((b, nb, Q_BLOCK) + a.shape[2:]), 1, 0)
        qcid = jnp.pad(cid, (0, pad), constant_values=BIG_CHUNK_ID).reshape(nb, Q_BLOCK)

        def block(args):
            qn_b, qr_b, qc_b = args
            return attn_probs_v(qn_b, qr_b, k_nope, kr_all, v, cid[None, :] <= qc_b[:, None])

        o = lax.map(block, (qblk(q_nope), qblk(q_rope), qcid))
        o = jnp.moveaxis(o, 0, 1).reshape(b, nb * Q_BLOCK, MLA_HEADS, MLA_V)[:, :L]
    else:
        o = attn_probs_v(q_nope, q_rope, k_nope, kr_all, v, None)
    return o.reshape(b, t, MLA_HEADS * MLA_V), ckv_new, kr_new


def mixer_ab(hn, pos, S0, conv_prev, cache_ckv, cache_kr, w_in, w_out, conv_w, A_log, dt_bias, o_norm,
             q_norm, w_uq, kv_norm, w_ukv, qn_norm, qr_norm, kn_norm, kr_norm):
    h = hn @ w_in
    o_g, S_new, conv_new = gdn_mixer(h[..., :GDN_COLS], S0, conv_prev, conv_w, A_log, dt_bias, o_norm)
    o_m, ckv_new, kr_new = mla_mixer(h[..., GDN_COLS:], pos, cache_ckv, cache_kr, q_norm, w_uq, kv_norm,
                                     w_ukv, qn_norm, qr_norm, kn_norm, kr_norm)
    y = jnp.concatenate([o_g, o_m], -1) @ w_out
    return y, ckv_new, kr_new, S_new, conv_new


def short_conv_mixer(hn, prev, w_in, conv_w, w_out):
    bg, cg, xin = jnp.split(hn @ w_in, 3, axis=-1)
    y, new_prev = causal_dwconv(cg * xin, conv_w, prev)
    return (bg * y) @ w_out, new_prev


def setup_inputs(seed: int = 0) -> dict:
    key = jax.random.key(seed)
    ks = iter(jax.random.split(key, 64))
    f32 = jnp.float32
    nrm = lambda shape, scale: jax.random.normal(next(ks), shape, f32) * scale
    gain = lambda shape: 1.0 + 0.02 * jax.random.normal(next(ks), shape, f32)
    NA, NC = N_A_LAYERS, N_C_LAYERS
    dt = jnp.exp(jax.random.uniform(next(ks), (NA, GDN_HEADS), f32, math.log(1e-3), math.log(1e-1)))
    return {
        'x_prompt': nrm((BATCH, SEQ, D_MODEL), 1.0),
        'x_sample': nrm((DEC_BATCH, DEC_SEQ, D_MODEL), 1.0),
        'cache_mla_ckv': nrm((NA, DEC_BATCH, PAST_LEN, MLA_KV_RANK), 1.0),
        'cache_mla_krope': nrm((NA, DEC_BATCH, PAST_LEN, MLA_ROPE), 1.0),
        'state_gdn_S': nrm((NA, DEC_BATCH, GDN_HEADS, GDN_DK, GDN_DV), 0.1),
        'state_gdn_conv': nrm((NA, DEC_BATCH, GDN_CONV - 1, GDN_QKV), 1.0),
        'state_sconv': nrm((NC, DEC_BATCH, SC_WIDTH - 1, D_MODEL), 1.0),
        'meta_tokens': nrm((N_META, D_MODEL), 1.0),
        'ffn1_norm': gain((DEPTH, D_MODEL)),
        'ffn1_w_gate': nrm((DEPTH, D_MODEL, D_FF), D_MODEL ** -0.5),
        'ffn1_w_up': nrm((DEPTH, D_MODEL, D_FF), D_MODEL ** -0.5),
        'ffn1_w_down': nrm((DEPTH, D_FF, D_MODEL), D_FF ** -0.5),
        'ffn2_norm': gain((DEPTH, D_MODEL)),
        'ffn2_w_gate': nrm((DEPTH, D_MODEL, D_FF), D_MODEL ** -0.5),
        'ffn2_w_up': nrm((DEPTH, D_MODEL, D_FF), D_MODEL ** -0.5),
        'ffn2_w_down': nrm((DEPTH, D_FF, D_MODEL), D_FF ** -0.5),
        'mix_norm': gain((DEPTH, D_MODEL)),
        'ab_w_in': nrm((NA, D_MODEL, IN_COLS), D_MODEL ** -0.5),
        'ab_w_out': nrm((NA, MIX_WIDTH, D_MODEL), MIX_WIDTH ** -0.5),
        'gdn_conv_w': nrm((NA, GDN_CONV, GDN_QKV), GDN_CONV ** -0.5),
        'gdn_A_log': jnp.log(jax.random.uniform(next(ks), (NA, GDN_HEADS), f32, 1.0, 16.0)),
        'gdn_dt_bias': dt + jnp.log(-jnp.expm1(-dt)),
        'gdn_o_norm': gain((NA, GDN_DV)),
        'mla_q_norm': gain((NA, MLA_Q_RANK)),
        'mla_w_uq': nrm((NA, MLA_Q_RANK, MLA_HEADS * (MLA_NOPE + MLA_ROPE)), MLA_Q_RANK ** -0.5),
        'mla_kv_norm': gain((NA, MLA_KV_RANK)),
        'mla_w_ukv': nrm((NA, MLA_KV_RANK, MLA_HEADS * (MLA_NOPE + MLA_V)), MLA_KV_RANK ** -0.5),
        'mla_qn_norm': gain((NA, MLA_NOPE)),
        'mla_qr_norm': gain((NA, MLA_ROPE)),
        'mla_kn_norm': gain((NA, MLA_NOPE)),
        'mla_kr_norm': gain((NA, MLA_ROPE)),
        'sc_w_in': nrm((NC, D_MODEL, 3 * D_MODEL), D_MODEL ** -0.5),
        'sc_conv_w': nrm((NC, SC_WIDTH, D_MODEL), SC_WIDTH ** -0.5),
        'sc_w_out': nrm((NC, D_MODEL, D_MODEL), D_MODEL ** -0.5),
    }


def reference(x_prompt, x_sample, cache_mla_ckv, cache_mla_krope, state_gdn_S, state_gdn_conv, state_sconv,
              meta_tokens, ffn1_norm, ffn1_w_gate, ffn1_w_up, ffn1_w_down, ffn2_norm, ffn2_w_gate, ffn2_w_up,
              ffn2_w_down, mix_norm, ab_w_in, ab_w_out, gdn_conv_w, gdn_A_log, gdn_dt_bias, gdn_o_norm,
              mla_q_norm, mla_w_uq, mla_kv_norm, mla_w_ukv, mla_qn_norm, mla_qr_norm, mla_kn_norm, mla_kr_norm,
              sc_w_in, sc_conv_w, sc_w_out):
    bp, tp = x_prompt.shape[0], x_prompt.shape[1]
    bs, ts = x_sample.shape[0], x_sample.shape[1]
    dtype = x_prompt.dtype
    xp = jnp.concatenate([jnp.broadcast_to(meta_tokens.astype(dtype)[None], (bp, N_META, D_MODEL)), x_prompt], 1)
    xs = x_sample
    pos_p = jnp.arange(N_META + tp)
    pos_s = PAST_LEN + jnp.arange(ts)
    p_ckv, p_kr, p_S, p_conv, p_sc = [], [], [], [], []
    s_ckv, s_kr, s_S, s_conv, s_sc = [], [], [], [], []
    for l in range(DEPTH):
        xp = half_ffn(xp, ffn1_norm[l], ffn1_w_gate[l], ffn1_w_up[l], ffn1_w_down[l])
        xs = half_ffn(xs, ffn1_norm[l], ffn1_w_gate[l], ffn1_w_up[l], ffn1_w_down[l])
        hp, hs = rms_norm(xp, mix_norm[l]), rms_norm(xs, mix_norm[l])
        if l % 2 == 0:
            i = l // 2
            wa = (ab_w_in[i], ab_w_out[i], gdn_conv_w[i], gdn_A_log[i], gdn_dt_bias[i], gdn_o_norm[i],
                  mla_q_norm[i], mla_w_uq[i], mla_kv_norm[i], mla_w_ukv[i], mla_qn_norm[i], mla_qr_norm[i],
                  mla_kn_norm[i], mla_kr_norm[i])
            S0p = jnp.zeros((bp, GDN_HEADS, GDN_DK, GDN_DV), dtype)
            c0p = jnp.zeros((bp, GDN_CONV - 1, GDN_QKV), dtype)
            yp, ckv, kr, S, cv = mixer_ab(hp, pos_p, S0p, c0p, None, None, *wa)
            p_ckv.append(ckv); p_kr.append(kr); p_S.append(S); p_conv.append(cv)
            ys, ckv, kr, S, cv = mixer_ab(hs, pos_s, state_gdn_S[i], state_gdn_conv[i], cache_mla_ckv[i],
                                          cache_mla_krope[i], *wa)
            s_ckv.append(ckv); s_kr.append(kr); s_S.append(S); s_conv.append(cv)
        else:
            i = l // 2
            yp, cp = short_conv_mixer(hp, jnp.zeros((bp, SC_WIDTH - 1, D_MODEL), dtype), sc_w_in[i], sc_conv_w[i], sc_w_out[i])
            ys, cs = short_conv_mixer(hs, state_sconv[i], sc_w_in[i], sc_conv_w[i], sc_w_out[i])
            p_sc.append(cp); s_sc.append(cs)
        xp, xs = xp + yp, xs + ys
        xp = half_ffn(xp, ffn2_norm[l], ffn2_w_gate[l], ffn2_w_up[l], ffn2_w_down[l])
        xs = half_ffn(xs, ffn2_norm[l], ffn2_w_gate[l], ffn2_w_up[l], ffn2_w_down[l])
    y_prompt = xp[:, N_META:]
    y_sample = xs
    return (y_prompt, y_sample,
            jnp.stack(p_ckv), jnp.stack(p_kr), jnp.stack(p_S), jnp.stack(p_conv), jnp.stack(p_sc),
            jnp.stack(s_ckv), jnp.stack(s_kr), jnp.stack(s_S), jnp.stack(s_conv), jnp.stack(s_sc))
```

```cpp
#include <hip/hip_runtime.h>
#include <hip/hip_cooperative_groups.h>
#include <cstdio>
namespace cg = cooperative_groups;

#define LAS __attribute__((address_space(3)))
typedef unsigned short bf16_t;
typedef short bf16x8 __attribute__((ext_vector_type(8)));
typedef short bf16x4 __attribute__((ext_vector_type(4)));
typedef float f32x4 __attribute__((ext_vector_type(4)));
typedef unsigned u32x4 __attribute__((ext_vector_type(4)));
typedef unsigned u32x2 __attribute__((ext_vector_type(2)));

constexpr int DM = 1024, LSEQ = 4112, NP = 8 * LSEQ  , NS = 512, MT = NP + NS  , MP = 33536  ;
constexpr int DFF = 2816, HINW = 2816;
constexpr int MK = NP + 8 * 1088  , MKP = 41728  ;
constexpr float EPS = 1e-6f;
constexpr int N_G1_ITEMS = 8 * 4 * 65 + 32;

constexpr size_t SZ_WGU = (size_t)5632 * 1024 * 2, SZ_WD = (size_t)1024 * 2816 * 2;
constexpr size_t OFF_WGU = 0;
constexpr size_t OFF_WD = OFF_WGU + 4 * SZ_WGU;
constexpr size_t OFF_WIN = OFF_WD + 4 * SZ_WD;
constexpr size_t OFF_WOUT = OFF_WIN + (size_t)2816 * 1024 * 2;
constexpr size_t OFF_WUQ = OFF_WOUT + (size_t)1024 * 1024 * 2;
constexpr size_t OFF_WUKVK = OFF_WUQ + (size_t)768 * 384 * 2;
constexpr size_t OFF_WUKVV = OFF_WUKVK + (size_t)512 * 256 * 2;
constexpr size_t OFF_WSCIN = OFF_WUKVV + (size_t)512 * 256 * 2;
constexpr size_t OFF_WSCOUT = OFF_WSCIN + (size_t)3072 * 1024 * 2;
constexpr size_t OFF_ROPE = OFF_WSCOUT + (size_t)1024 * 1024 * 2;
constexpr size_t OFF_RSS = OFF_ROPE + (size_t)LSEQ * 16 * 8;
constexpr size_t OFF_X = OFF_RSS + (size_t)6 * MP * 4;
constexpr size_t OFF_H = OFF_X + (size_t)MP * 1024 * 4;
constexpr size_t OFF_GU = OFF_H + (size_t)MP * 1024 * 2;
constexpr size_t OFF_SPARE = OFF_GU + (size_t)MP * 2816 * 2;
constexpr size_t OFF_KTT = OFF_SPARE;
constexpr size_t OFF_QK = OFF_KTT + (size_t)N_G1_ITEMS * 16384;
constexpr size_t OFF_GL = OFF_QK + (size_t)N_G1_ITEMS * 8192;
constexpr size_t OFF_FLG = OFF_GL + (size_t)N_G1_ITEMS * 4;
constexpr size_t END_GDN = OFF_FLG + (size_t)N_G1_ITEMS * 4;
constexpr size_t OFF_CQ = OFF_SPARE;
constexpr size_t OFF_CKVA = OFF_CQ + (size_t)MP * 384 * 2;
constexpr size_t OFF_KRA = OFF_CKVA + (size_t)MKP * 256 * 2;
constexpr size_t END_MLA = OFF_KRA + (size_t)MKP * 32 * 2;
constexpr size_t WS_NEED = (END_GDN > END_MLA ? END_GDN : END_MLA);
constexpr size_t OFF_Q = OFF_GU;
constexpr size_t OFF_KN = OFF_Q + (size_t)MP * 768 * 2;
constexpr size_t OFF_VT = OFF_KN + (size_t)MKP * 512 * 2;
constexpr size_t OFF_P = OFF_GU;
constexpr size_t OFF_BG = OFF_P + (size_t)MP * 1024 * 2;
static_assert(OFF_VT + (size_t)512 * MKP * 2 <= OFF_SPARE, "GU region overflow");
static_assert(WS_NEED <= (size_t)536870912, "workspace overflow");
constexpr size_t DO_WK = 0, DO_UT = (size_t)N_G1_ITEMS * 16384, DO_QD = 2 * (size_t)N_G1_ITEMS * 16384;
static_assert(3 * (size_t)N_G1_ITEMS * 16384 <= (size_t)33554432 * 4, "d_out scratch overflow");
constexpr size_t OFF_YP = 0, OFF_YS = 33554432, OFF_PCKV = 34078720, OFF_PKR = 42500096, OFF_PS = 43552768, OFF_PCONV = 44077056,
                 OFF_PSC = 44113920, OFF_SCKV = 44130304, OFF_SKR = 44261376, OFF_SS = 44277760, OFF_SCONV = 44802048, OFF_SSC = 44838912;

constexpr int LDS_BYTES = 152576 + 16;

struct Params {
    const float* in[34];
    float* out;
    unsigned char* ws;
};

__device__ const double kRopeInv[16] = {1.0, 0.5623413251903491, 0.31622776601683794, 0.1778279410038923, 0.1, 0.05623413251903491, 0.031622776601683794, 0.01778279410038923,
                                       0.01, 0.005623413251903491, 0.0031622776601683794, 0.001778279410038923, 0.001, 0.0005623413251903491, 0.00031622776601683794, 0.0001778279410038923};
__device__ __forceinline__ float bf2f(bf16_t h) { return __uint_as_float(((unsigned)h) << 16); }
__device__ __forceinline__ bf16_t f2bf(float f) { unsigned u = __float_as_uint(f); u += 0x7fffu + ((u >> 16) & 1u); return (bf16_t)(u >> 16); }
typedef float f32x2_t __attribute__((ext_vector_type(2)));
typedef __bf16 bf16x2_t __attribute__((ext_vector_type(2)));
__device__ __forceinline__ unsigned cvt_pk_bf16(float lo, float hi) { const f32x2_t v = {lo, hi}; return __builtin_bit_cast(unsigned, __builtin_convertvector(v, bf16x2_t)); }
__device__ __forceinline__ float wsum(float v) {
#pragma unroll
    for (int o = 32; o > 0; o >>= 1) v += __shfl_xor(v, o);
    return v;
}
__device__ __forceinline__ float silu_f(float x) { return x * __builtin_amdgcn_rcpf(1.0f + __expf(-x)); }
__device__ __forceinline__ float row_rs(const float* rssp, int row) {
    const f32x4 a = *(const f32x4*)(rssp + (size_t)row * 16), b = *(const f32x4*)(rssp + (size_t)row * 16 + 4);
    const f32x4 c = *(const f32x4*)(rssp + (size_t)row * 16 + 8), d = *(const f32x4*)(rssp + (size_t)row * 16 + 12);
    const f32x4 t = (a + b) + (c + d);
    return rsqrtf(((t[0] + t[1]) + (t[2] + t[3])) * (1.0f / 1024.0f) + EPS);
}
__device__ __forceinline__ void row_rs8(const float* rssp, int row0, int fq, float (&rsv)[2][4]) {
    f32x4 t[2][4];
#pragma unroll
    for (int ai = 0; ai < 2; ++ai)
#pragma unroll
        for (int m = 0; m < 4; ++m) t[ai][m] = *(const f32x4*)(rssp + (size_t)(row0 + ai * 128 + m * 16) * 16 + 4 * fq);
#pragma unroll
    for (int ai = 0; ai < 2; ++ai)
#pragma unroll
        for (int m = 0; m < 4; ++m) {
            float sv = (t[ai][m][0] + t[ai][m][1]) + (t[ai][m][2] + t[ai][m][3]);
            sv += __shfl_xor(sv, 16); sv += __shfl_xor(sv, 32);
            rsv[ai][m] = rsqrtf(sv * (1.0f / 1024.0f) + EPS);
        }
}
__device__ __forceinline__ void row_rs8_lds(LAS float* rsb, int ui, int wr, int fr, float (&rsv)[2][4]) {
#pragma unroll
    for (int ai = 0; ai < 2; ++ai)
#pragma unroll
        for (int m = 0; m < 4; ++m) rsv[ai][m] = rsb[ui * 256 + ai * 128 + wr * 64 + m * 16 + fr];
}
__device__ __forceinline__ f32x4 mfma16(bf16x8 a, bf16x8 b, f32x4 c) { return __builtin_amdgcn_mfma_f32_16x16x32_bf16(a, b, c, 0, 0, 0); }

namespace pg8 {
constexpr int BM = 256, BK = 64, HALF = 128, HTB = HALF * BK * 2, STAGE_BYTES = 8 * HTB, NXCD = 8, WGM = 8;
__device__ __forceinline__ int lds_byte(int r, int c) { const int st = (r >> 4) * 2 + (c >> 5), rr = r & 15, cc = c & 31, ob = rr * 64 + cc * 2; return st * 1024 + (ob ^ (((ob >> 9) & 1) << 5)); }
__device__ __forceinline__ void stage_rc(int b, int& R, int& C) { const int st = b / 1024, sb = b % 1024, swz = sb ^ (((sb >> 9) & 1) << 5); R = (st >> 1) * 16 + swz / 64; C = (st & 1) * 32 + (swz % 64) / 2; }
__device__ __forceinline__ int perm32(int rho) { const int n = rho >> 4, i = rho & 15; return 8 * (i >> 2) + 4 * n + (i & 3); }
struct Unit { int pm, pn; };
struct Gemm { const bf16_t* A; const bf16_t* Bt; int M, N, K; };
struct StaticOrder {
    int nM, nN, nwg, G, c, strip, pm0, pn0, pstep;
    __device__ void init(int M, int N, int G_, int c_) { nM = M / BM; nN = N / BM; nwg = nM * nN; G = G_; c = c_; strip = 0; pm0 = 0; pn0 = 0; pstep = 1; }
    __device__ void init_strip(int N, int pm0_, int pn0_, int pstep_) { nM = 1; nN = N / BM; nwg = 0; G = 1; c = 0; strip = 1; pm0 = pm0_; pn0 = pn0_; pstep = pstep_; }
    __device__ bool next(int i, Unit& u) const {
        if (strip) { const int pn = pn0 + i * pstep; if (pn >= nN) return false; u.pm = pm0; u.pn = pn; return true; }
        const long L = (long)i * G + c; if (L >= nwg) return false;
        int wgid = (int)L; { const int q = nwg / NXCD, r = nwg % NXCD, xcd = wgid % NXCD, off = wgid / NXCD; wgid = (xcd < r ? xcd * (q + 1) : r * (q + 1) + (xcd - r) * q) + off; }
        const int nig = WGM * nN, gid = wgid / nig, fm = gid * WGM, gsz = (nM - fm) < WGM ? (nM - fm) : WGM;
        u.pm = fm + ((wgid % nig) % gsz); u.pn = (wgid % nig) / gsz; return true;
    }
};
template <class Epi>
__device__ __forceinline__ void gemm_phase(LAS unsigned char* lds, const Gemm g, const StaticOrder& S, const Epi& E, const int tid) {
    const int wid = __builtin_amdgcn_readfirstlane(tid >> 6), lane = tid & 63, wr = wid >> 2, wc = wid & 3, fr = lane & 15, fq = lane >> 4;
    const int K = g.K, nt = K / BK;
    unsigned voffA[2], voffB[2];
#pragma unroll
    for (int i = 0; i < 2; ++i) { int R, C; stage_rc(tid * 16 + i * 8192, R, C); const int Rb = Epi::PERM ? ((R & ~31) + perm32(R & 31)) : R;
        voffA[i] = (unsigned)(R * K + C) * 2u; voffB[i] = (unsigned)(Rb * K + C) * 2u; }
    const size_t kstep = (size_t)(BK * 2);
    const size_t hstep = (size_t)HALF * K * 2;
    const size_t tstep = 2 * hstep;
    const unsigned ldsw = (unsigned)wid * 1024u;
    const int aoff = lds_byte(wr * 64 + fr, fq * 8), boff = lds_byte(wc * 32 + fr, fq * 8);
#define PG8_SA(b, h) (((b) * 2 + (h)) * HTB)
#define PG8_SB(b, h) ((4 + (b) * 2 + (h)) * HTB)
#define PG8_STAGE(bufoff, gbase, voff) do { _Pragma("unroll") for (int _i = 0; _i < 2; ++_i) \
        __builtin_amdgcn_global_load_lds((const unsigned*)((const char*)(gbase) + (voff)[_i]), (LAS unsigned*)(lds + (bufoff) + ldsw + _i * 8192), 16, 0, 0); } while (0)
#define PG8_LDA(dst, b, h) do { _Pragma("unroll") for (int m = 0; m < 4; ++m) _Pragma("unroll") for (int k = 0; k < 2; ++k) dst[m][k] = *(const LAS bf16x8*)(lds + PG8_SA(b, h) + aoff + m * 2048 + k * 1024); } while (0)
#define PG8_LDB(dst, b, h) do { _Pragma("unroll") for (int n = 0; n < 2; ++n) _Pragma("unroll") for (int k = 0; k < 2; ++k) dst[n][k] = *(const LAS bf16x8*)(lds + PG8_SB(b, h) + boff + n * 2048 + k * 1024); } while (0)
#define PG8_MMA(ai, bj, At, Bt) do { __builtin_amdgcn_s_setprio(1); _Pragma("unroll") for (int m = 0; m < 4; ++m) _Pragma("unroll") for (int n = 0; n < 2; ++n) _Pragma("unroll") for (int k = 0; k < 2; ++k) \
        acc[ai][bj][m][n] = __builtin_amdgcn_mfma_f32_16x16x32_bf16(Bt[n][k], At[m][k], acc[ai][bj][m][n], 0, 0, 0); __builtin_amdgcn_s_setprio(0); } while (0)
#define PG8_WAIT_V(n) asm volatile("s_waitcnt vmcnt(" #n ")" ::: "memory")
#define PG8_WAIT_L(n) asm volatile("s_waitcnt lgkmcnt(" #n ")" ::: "memory")
#define PG8_BAR __builtin_amdgcn_s_barrier()
#define PG8_SCHED __builtin_amdgcn_sched_barrier(0)
    Unit cur, nxt; int ui = 0;
    if (!S.next(0, cur)) return;
    f32x4 acc[2][2][4][2];
#pragma unroll
    for (int a = 0; a < 2; ++a)
#pragma unroll
        for (int b = 0; b < 2; ++b)
#pragma unroll
            for (int m = 0; m < 4; ++m)
#pragma unroll
                for (int n = 0; n < 2; ++n) acc[a][b][m][n] = (f32x4){0.f, 0.f, 0.f, 0.f};
    bf16x8 At[4][2], B0[2][2], B1[2][2];
    const char* cA = (const char*)g.A + (size_t)cur.pm * tstep; const char* cB = (const char*)g.Bt + (size_t)cur.pn * tstep;
    PG8_STAGE(PG8_SB(0, 0), cB, voffB); PG8_STAGE(PG8_SA(0, 0), cA, voffA); PG8_STAGE(PG8_SB(0, 1), cB + hstep, voffB); PG8_STAGE(PG8_SA(0, 1), cA + hstep, voffA);
    if (wr == 1) PG8_BAR;
    PG8_WAIT_V(4); PG8_BAR;
    PG8_STAGE(PG8_SB(1, 0), cB + kstep, voffB); PG8_STAGE(PG8_SA(1, 0), cA + kstep, voffA); PG8_STAGE(PG8_SB(1, 1), cB + hstep + kstep, voffB);
    PG8_WAIT_V(6); PG8_BAR;
    for (;;) {
        const bool has_next = S.next(ui + 1, nxt);
        const char* nA = has_next ? (const char*)g.A + (size_t)nxt.pm * tstep : cA; const char* nB = has_next ? (const char*)g.Bt + (size_t)nxt.pn * tstep : cB;
#pragma unroll 1
        for (int t = 0; t < nt; t += 2) {
            const bool last = (t == nt - 2);
            const char* a1 = cA + (size_t)(t + 1) * kstep;
            const char* a2 = last ? nA : cA + (size_t)(t + 2) * kstep; const char* b2 = last ? nB : cB + (size_t)(t + 2) * kstep;
            const char* a3 = a2 + kstep; const char* b3 = b2 + kstep;
            PG8_LDB(B0, 0, 0); PG8_SCHED; PG8_LDA(At, 0, 0); PG8_STAGE(PG8_SA(1, 1), a1 + hstep, voffA);
            PG8_WAIT_L(8); PG8_BAR; PG8_WAIT_L(0); PG8_MMA(0, 0, At, B0); PG8_BAR; PG8_SCHED;
            PG8_LDB(B1, 0, 1); PG8_STAGE(PG8_SB(0, 0), b2, voffB);
            PG8_BAR; PG8_WAIT_L(0); PG8_MMA(0, 1, At, B1); PG8_BAR;
            PG8_LDA(At, 0, 1); PG8_STAGE(PG8_SA(0, 0), a2, voffA);
            PG8_BAR; PG8_WAIT_L(0); PG8_MMA(1, 0, At, B0); PG8_BAR; PG8_SCHED;
            PG8_STAGE(PG8_SB(0, 1), b2 + hstep, voffB);
            PG8_WAIT_V(6); PG8_BAR; PG8_MMA(1, 1, At, B1); PG8_BAR;
            PG8_LDB(B0, 1, 0); PG8_SCHED; PG8_LDA(At, 1, 0); PG8_STAGE(PG8_SA(0, 1), a2 + hstep, voffA);
            PG8_WAIT_L(8); PG8_BAR; PG8_WAIT_L(0); PG8_MMA(0, 0, At, B0); PG8_BAR; PG8_SCHED;
            PG8_LDB(B1, 1, 1); PG8_STAGE(PG8_SB(1, 0), b3, voffB);
            PG8_BAR; PG8_WAIT_L(0); PG8_MMA(0, 1, At, B1); PG8_BAR;
            PG8_LDA(At, 1, 1); PG8_STAGE(PG8_SA(1, 0), a3, voffA);
            PG8_BAR; PG8_WAIT_L(0); PG8_MMA(1, 0, At, B0); PG8_BAR; PG8_SCHED;
            PG8_STAGE(PG8_SB(1, 1), b3 + hstep, voffB);
            PG8_WAIT_V(6); PG8_BAR; PG8_MMA(1, 1, At, B1); PG8_BAR;
        }
        E(acc, cur, wr, wc, fr, fq, ui);
        if (!has_next) break;
#pragma unroll
        for (int a = 0; a < 2; ++a)
#pragma unroll
            for (int b = 0; b < 2; ++b)
#pragma unroll
                for (int m = 0; m < 4; ++m)
#pragma unroll
                    for (int n = 0; n < 2; ++n) acc[a][b][m][n] = (f32x4){0.f, 0.f, 0.f, 0.f};
        cur = nxt; cA = nA; cB = nB; ++ui;
    }
    PG8_WAIT_V(0);
    if (wr == 0) PG8_BAR;
    PG8_BAR;
#undef PG8_SA
#undef PG8_SB
#undef PG8_STAGE
#undef PG8_LDA
#undef PG8_LDB
#undef PG8_MMA
#undef PG8_WAIT_V
#undef PG8_WAIT_L
#undef PG8_BAR
#undef PG8_SCHED
}
}
using pg8::Unit;
typedef f32x4 AccT[2][2][4][2];

struct EpiGU {
    static constexpr bool PERM = true, NEEDS_RS = true;
    bf16_t* O; const float* rss; LAS float* rsb;
    __device__ __forceinline__ void operator()(const AccT& acc, const Unit& u, int wr, int wc, int fr, int fq, int ui) const {
        const int row0 = u.pm * 256 + wr * 64 + fr, col0 = u.pn * 128 + wc * 32 + 8 * fq;
        float rsv[2][4]; row_rs8_lds(rsb, ui, wr, fr, rsv);
#pragma unroll
        for (int ai = 0; ai < 2; ++ai)
#pragma unroll
            for (int m = 0; m < 4; ++m) {
                asm volatile("" ::: "memory");
                const float rs = rsv[ai][m];
                const f32x4 g0 = acc[ai][0][m][0] * rs, g1 = acc[ai][0][m][1] * rs, u0 = acc[ai][1][m][0] * rs, u1 = acc[ai][1][m][1] * rs;
                float v[8];
#pragma unroll
                for (int j = 0; j < 4; ++j) { v[j] = silu_f(g0[j]) * u0[j]; v[4 + j] = silu_f(g1[j]) * u1[j]; }
                u32x4 w; w.x = cvt_pk_bf16(v[0], v[1]); w.y = cvt_pk_bf16(v[2], v[3]); w.z = cvt_pk_bf16(v[4], v[5]); w.w = cvt_pk_bf16(v[6], v[7]);
                *(u32x4*)(O + (size_t)(row0 + ai * 128 + m * 16) * DFF + col0) = w;
            }
    }
};
struct EpiBf16 {
    static constexpr bool PERM = true, NEEDS_RS = true;
    bf16_t* O; int ldc; const float* rss; LAS float* rsb;
    __device__ __forceinline__ void operator()(const AccT& acc, const Unit& u, int wr, int wc, int fr, int fq, int ui) const {
        const int row0 = u.pm * 256 + wr * 64 + fr, col0 = u.pn * 256 + wc * 32 + 8 * fq;
        float rsv[2][4];
        if (rss) row_rs8_lds(rsb, ui, wr, fr, rsv);
        else {
#pragma unroll
            for (int ai = 0; ai < 2; ++ai)
#pragma unroll
                for (int m = 0; m < 4; ++m) rsv[ai][m] = 1.0f;
        }
#pragma unroll
        for (int ai = 0; ai < 2; ++ai)
#pragma unroll
            for (int m = 0; m < 4; ++m) {
                asm volatile("" ::: "memory");
                bf16_t* rowp = O + (size_t)(row0 + ai * 128 + m * 16) * ldc + col0;
                const float rs = rsv[ai][m];
#pragma unroll
                for (int bj = 0; bj < 2; ++bj) {
                    const f32x4 v0 = acc[ai][bj][m][0] * rs, v1 = acc[ai][bj][m][1] * rs;
                    u32x4 w; w.x = cvt_pk_bf16(v0[0], v0[1]); w.y = cvt_pk_bf16(v0[2], v0[3]); w.z = cvt_pk_bf16(v1[0], v1[1]); w.w = cvt_pk_bf16(v1[2], v1[3]);
                    *(u32x4*)(rowp + bj * 128) = w;
                }
            }
    }
};
struct EpiAddX {
    static constexpr bool PERM = false, NEEDS_RS = false;
    float* X; float scale; float* out; int final_; bf16_t* xb; float* rss;
    __device__ __forceinline__ void operator()(const AccT& acc, const Unit& u, int wr, int wc, int fr, int fq, int ui) const {
        const int row0 = u.pm * 256 + wr * 64 + fr, col0 = u.pn * 256 + wc * 32 + 4 * fq;
#pragma unroll
        for (int ai = 0; ai < 2; ++ai)
#pragma unroll
            for (int m = 0; m < 4; ++m) {
                if (m == 0) asm volatile("" ::: "memory");
                const int row = row0 + ai * 128 + m * 16;
                if (row < MT) {
                    float* xp = X + (size_t)row * 1024 + col0;
                    float* dp = xp; bool wr_ok = true;
                    if (final_) {
                        if (row < NP) { const int b = row / LSEQ, pos = row - b * LSEQ; wr_ok = pos >= 16; dp = out + OFF_YP + ((size_t)(b * 4096 + pos - 16)) * 1024 + col0; }
                        else dp = out + OFF_YS + (size_t)(row - NP) * 1024 + col0;
                    }
                    if (wr_ok) {
                        float ss = 0.f;
#pragma unroll
                        for (int bj = 0; bj < 2; ++bj)
#pragma unroll
                            for (int n = 0; n < 2; ++n) {
                                const f32x4 x = *(const f32x4*)(xp + bj * 128 + n * 16);
                                const f32x4 y = x + scale * acc[ai][bj][m][n];
                                *(f32x4*)(dp + bj * 128 + n * 16) = y;
                                if (!final_) {
                                    ss += y[0] * y[0] + y[1] * y[1] + y[2] * y[2] + y[3] * y[3];
                                    u32x2 w; w.x = cvt_pk_bf16(y[0], y[1]); w.y = cvt_pk_bf16(y[2], y[3]);
                                    *(u32x2*)(xb + (size_t)row * 1024 + col0 + bj * 128 + n * 16) = w;
                                }
                            }
                        if (!final_) {
                            ss += __shfl_xor(ss, 16); ss += __shfl_xor(ss, 32);
                            if (fq == 0) rss[(size_t)row * 16 + u.pn * 4 + wc] = ss;
                        }
                    }
                }
            }
    }
};
struct EpiQ {
    static constexpr bool PERM = false, NEEDS_RS = false;
    bf16_t* Q; const float* qn; const float* qr; const float2* rope; float scale;
    __device__ __forceinline__ void operator()(const AccT& acc, const Unit& u, int wr, int wc, int fr, int fq, int ui) const {
        const int row0 = u.pm * 256 + wr * 64 + fr;
        if (u.pn < 2) {
            const int head = 4 * u.pn + wc;
            f32x4 gq[2][2];
#pragma unroll
            for (int bj = 0; bj < 2; ++bj)
#pragma unroll
                for (int n = 0; n < 2; ++n) gq[bj][n] = *(const f32x4*)(qn + 32 * bj + 16 * n + 4 * fq);
#pragma unroll
            for (int ai = 0; ai < 2; ++ai)
#pragma unroll
                for (int m = 0; m < 4; ++m) {
                    asm volatile("" ::: "memory");
                    const int row = row0 + ai * 128 + m * 16;
                    float ss = 0.f;
#pragma unroll
                    for (int bj = 0; bj < 2; ++bj)
#pragma unroll
                        for (int n = 0; n < 2; ++n) { const f32x4 x = acc[ai][bj][m][n]; ss += x[0] * x[0] + x[1] * x[1] + x[2] * x[2] + x[3] * x[3]; }
                    ss += __shfl_xor(ss, 16); ss += __shfl_xor(ss, 32);
                    const float r = rsqrtf(ss * (1.0f / 64.0f) + EPS) * scale;
#pragma unroll
                    for (int bj = 0; bj < 2; ++bj)
#pragma unroll
                        for (int n = 0; n < 2; ++n) {
                            const f32x4 x = acc[ai][bj][m][n], g = gq[bj][n];
                            u32x2 w; w.x = cvt_pk_bf16(x[0] * r * g[0], x[1] * r * g[1]); w.y = cvt_pk_bf16(x[2] * r * g[2], x[3] * r * g[3]);
                            *(u32x2*)(Q + (size_t)row * 768 + head * 64 + 32 * bj + 16 * n + 4 * fq) = w;
                        }
                }
        } else {
            const f32x4 g1 = *(const f32x4*)(qr + 4 * fq), g2 = *(const f32x4*)(qr + 16 + 4 * fq);
#pragma unroll
            for (int ai = 0; ai < 2; ++ai)
#pragma unroll
                for (int m = 0; m < 4; ++m) {
                    asm volatile("" ::: "memory");
                    const int row = row0 + ai * 128 + m * 16;
                    int pos = 0;
                    if (row < NP) pos = row % LSEQ; else if (row < MT) pos = 1024 + ((row - NP) & 63);
                    const float2* rp = rope + pos * 16 + 4 * fq;
                    float2 cs[4];
#pragma unroll
                    for (int j = 0; j < 4; ++j) cs[j] = rp[j];
#pragma unroll
                    for (int bj = 0; bj < 2; ++bj) {
                        const int head = 4 * bj + wc;
                        const f32x4 x1 = acc[ai][bj][m][0], x2 = acc[ai][bj][m][1];
                        float ss = x1[0] * x1[0] + x1[1] * x1[1] + x1[2] * x1[2] + x1[3] * x1[3] + x2[0] * x2[0] + x2[1] * x2[1] + x2[2] * x2[2] + x2[3] * x2[3];
                        ss += __shfl_xor(ss, 16); ss += __shfl_xor(ss, 32);
                        const float r = rsqrtf(ss * (1.0f / 32.0f) + EPS);
                        float o1[4], o2[4];
#pragma unroll
                        for (int j = 0; j < 4; ++j) {
                            const float y1 = x1[j] * r * g1[j], y2 = x2[j] * r * g2[j];
                            o1[j] = (y1 * cs[j].x - y2 * cs[j].y) * scale; o2[j] = (y2 * cs[j].x + y1 * cs[j].y) * scale;
                        }
                        u32x2 w1, w2; w1.x = cvt_pk_bf16(o1[0], o1[1]); w1.y = cvt_pk_bf16(o1[2], o1[3]); w2.x = cvt_pk_bf16(o2[0], o2[1]); w2.y = cvt_pk_bf16(o2[2], o2[3]);
                        bf16_t* qp = Q + (size_t)row * 768 + 512 + head * 32 + 4 * fq;
                        *(u32x2*)qp = w1; *(u32x2*)(qp + 16) = w2;
                    }
                }
        }
    }
};
struct EpiKN {
    static constexpr bool PERM = false, NEEDS_RS = false;
    bf16_t* KN; const float* kn;
    __device__ __forceinline__ void operator()(const AccT& acc, const Unit& u, int wr, int wc, int fr, int fq, int ui) const {
        const int row0 = u.pm * 256 + wr * 64 + fr, head = 4 * u.pn + wc;
        f32x4 gk[2][2];
#pragma unroll
        for (int bj = 0; bj < 2; ++bj)
#pragma unroll
            for (int n = 0; n < 2; ++n) gk[bj][n] = *(const f32x4*)(kn + 32 * bj + 16 * n + 4 * fq);
#pragma unroll
        for (int ai = 0; ai < 2; ++ai)
#pragma unroll
            for (int m = 0; m < 4; ++m) {
                asm volatile("" ::: "memory");
                const int row = row0 + ai * 128 + m * 16;
                float ss = 0.f;
#pragma unroll
                for (int bj = 0; bj < 2; ++bj)
#pragma unroll
                    for (int n = 0; n < 2; ++n) { const f32x4 x = acc[ai][bj][m][n]; ss += x[0] * x[0] + x[1] * x[1] + x[2] * x[2] + x[3] * x[3]; }
                ss += __shfl_xor(ss, 16); ss += __shfl_xor(ss, 32);
                const float r = rsqrtf(ss * (1.0f / 64.0f) + EPS);
#pragma unroll
                for (int bj = 0; bj < 2; ++bj)
#pragma unroll
                    for (int n = 0; n < 2; ++n) {
                        const f32x4 x = acc[ai][bj][m][n], g = gk[bj][n];
                        u32x2 w; w.x = cvt_pk_bf16(x[0] * r * g[0], x[1] * r * g[1]); w.y = cvt_pk_bf16(x[2] * r * g[2], x[3] * r * g[3]);
                        *(u32x2*)(KN + (size_t)row * 512 + head * 64 + 32 * bj + 16 * n + 4 * fq) = w;
                    }
            }
    }
};
struct EpiSC {
    static constexpr bool PERM = true, NEEDS_RS = true;
    bf16_t* Pb; bf16_t* BG; const float* rss; LAS float* rsb;
    __device__ __forceinline__ void operator()(const AccT& acc, const Unit& u, int wr, int wc, int fr, int fq, int ui) const {
        const int row0 = u.pm * 256 + wr * 64 + fr;
        float rsv[2][4]; row_rs8_lds(rsb, ui, wr, fr, rsv);
        if (u.pn < 8) {
            const int col0 = u.pn * 128 + wc * 32 + 8 * fq;
#pragma unroll
            for (int ai = 0; ai < 2; ++ai)
#pragma unroll
                for (int m = 0; m < 4; ++m) {
                    asm volatile("" ::: "memory");
                    const float rs = rsv[ai][m], rs2 = rs * rs;
                    const f32x4 c0 = acc[ai][0][m][0] * rs2, c1 = acc[ai][0][m][1] * rs2, x0 = acc[ai][1][m][0], x1 = acc[ai][1][m][1];
                    u32x4 w; w.x = cvt_pk_bf16(c0[0] * x0[0], c0[1] * x0[1]); w.y = cvt_pk_bf16(c0[2] * x0[2], c0[3] * x0[3]);
                    w.z = cvt_pk_bf16(c1[0] * x1[0], c1[1] * x1[1]); w.w = cvt_pk_bf16(c1[2] * x1[2], c1[3] * x1[3]);
                    *(u32x4*)(Pb + (size_t)(row0 + ai * 128 + m * 16) * 1024 + col0) = w;
                }
        } else {
            const int col0 = (u.pn - 8) * 256 + wc * 32 + 8 * fq;
#pragma unroll
            for (int ai = 0; ai < 2; ++ai)
#pragma unroll
                for (int m = 0; m < 4; ++m) {
                    asm volatile("" ::: "memory");
                    bf16_t* rowp = BG + (size_t)(row0 + ai * 128 + m * 16) * 1024 + col0;
                    const float rs = rsv[ai][m];
#pragma unroll
                    for (int bj = 0; bj < 2; ++bj) {
                        const f32x4 v0 = acc[ai][bj][m][0] * rs, v1 = acc[ai][bj][m][1] * rs;
                        u32x4 w; w.x = cvt_pk_bf16(v0[0], v0[1]); w.y = cvt_pk_bf16(v0[2], v0[3]); w.z = cvt_pk_bf16(v1[0], v1[1]); w.w = cvt_pk_bf16(v1[2], v1[3]);
                        *(u32x4*)(rowp + bj * 128) = w;
                    }
                }
        }
    }
};

template <class Epi>
__device__ __forceinline__ void run_gemm_order(LAS unsigned char* lds, const bf16_t* A, const bf16_t* Bt, int M, int N, int K, const Epi& E, int tid, const pg8::StaticOrder& S);
template <class Epi>
__device__ __forceinline__ void run_gemm(LAS unsigned char* lds, const bf16_t* A, const bf16_t* Bt, int M, int N, int K, const Epi& E, int tid, int bid, int Gv = 0) {
    asm volatile("" : "+v"(tid), "+s"(bid));
    pg8::StaticOrder S; S.init(M, N, Gv ? Gv : (int)gridDim.x, bid);
    run_gemm_order<Epi>(lds, A, Bt, M, N, K, E, tid, S);
}
template <class Epi>
__device__ __forceinline__ void run_gemm_strip(LAS unsigned char* lds, const bf16_t* A, const bf16_t* Bt, int N, int K, const Epi& E, int tid, int pm0, int pn0, int pstep) {
    asm volatile("" : "+v"(tid), "+s"(pm0));
    pg8::StaticOrder S; S.init_strip(N, pm0, pn0, pstep);
    run_gemm_order<Epi>(lds, A, Bt, 0, N, K, E, tid, S);
}
template <class Epi>
__device__ __forceinline__ void run_gemm_order(LAS unsigned char* lds, const bf16_t* A, const bf16_t* Bt, int M, int N, int K, const Epi& E, int tid, const pg8::StaticOrder& S) {
    pg8::Gemm g; g.A = A; g.Bt = Bt; g.M = M; g.N = N; g.K = K;
    if constexpr (Epi::NEEDS_RS) {
        if (E.rss) {
            LAS float* rsb = (LAS float*)(lds + 131072);
            const int r = tid >> 1, hf = tid & 1;
#pragma unroll 4
            for (int i = 0; i < 16; ++i) {
                pg8::Unit u; const bool ok = S.next(i, u); const int pm = ok ? u.pm : 0;
                const float* p = E.rss + ((size_t)(pm * 256 + r)) * 16 + 8 * hf;
                const f32x4 a = *(const f32x4*)p, b = *(const f32x4*)(p + 4);
                float sv = ((a[0] + a[1]) + (a[2] + a[3])) + ((b[0] + b[1]) + (b[2] + b[3]));
                sv += __shfl_xor(sv, 1);
                if (ok && hf == 0) rsb[i * 256 + r] = rsqrtf(sv * (1.0f / 1024.0f) + EPS);
            }
            __syncthreads();
        }
    }
    pg8::gemm_phase<Epi>(lds, g, S, E, tid);
    __syncthreads();
}

__device__ __forceinline__ int map_col(int type, int n, int ncols) {
    if (type == 0) return n < ncols ? n : -1;
    if (type == 1) { return 128 * (n >> 8) + (n & 127); }
    if (type == 2) {
        if (n < 512) { const int pn = n >> 8, rr = n & 255, bj = rr >> 7, wc = (rr >> 5) & 3, x = rr & 31; return (4 * pn + wc) * 96 + 32 * bj + x; }
        const int rr = n - 512, bj = rr >> 7, wc = (rr >> 5) & 3, x = rr & 31; return (4 * bj + wc) * 96 + 64 + x;
    }
    if (type == 3) { const int pn = n >> 8, rr = n & 255, bj = rr >> 7, wc = (rr >> 5) & 3, x = rr & 31; return (4 * pn + wc) * 128 + 32 * bj + x; }
    if (type == 4) return (n >> 6) * 128 + 64 + (n & 63);
    { const int pn = n >> 8, r = n & 255; if (pn < 8) return (r < 128 ? 1024 : 2048) + 128 * pn + (r & 127); return n - 2048; }
}

__device__ __forceinline__ void norm_row_store(const float4 (&v)[4], float ss, const float* g, bf16_t* h, int lane) {
    const float r = rsqrtf(ss * (1.0f / 1024.0f) + EPS);
#pragma unroll
    for (int i = 0; i < 4; ++i) {
        const float4 gg = ((const float4*)g)[lane + 64 * i];
        u32x2 w; w.x = cvt_pk_bf16(v[i].x * r * gg.x, v[i].y * r * gg.y); w.y = cvt_pk_bf16(v[i].z * r * gg.z, v[i].w * r * gg.w);
        *(u32x2*)(h + 4 * (lane + 64 * i)) = w;
    }
}

__device__ __forceinline__ void convert_tile(const Params& P, LAS unsigned char* L, const int tid, const int tile) {
    LAS float* T = (LAS float*)L;
    unsigned char* ws = P.ws;
    {
        const float* s0; const float* s1; bf16_t* dst; int ld, K, type, ncols, lt; const float* gk = nullptr;
        if (tile < 5632) { const int j = tile / 1408; lt = tile - j * 1408; const int l = j >> 1, f = j & 1;
            s0 = (f ? P.in[13] : P.in[9]) + (size_t)l * 1024 * 2816; s1 = (f ? P.in[14] : P.in[10]) + (size_t)l * 1024 * 2816;
            dst = (bf16_t*)(ws + OFF_WGU + (size_t)j * SZ_WGU); ld = 2816; K = 1024; type = 1; ncols = 2816; gk = (f ? P.in[12] : P.in[8]) + l * 1024; }
        else if (tile < 8448) { const int j = (tile - 5632) / 704; lt = (tile - 5632) - j * 704; const int l = j >> 1, f = j & 1;
            s0 = (f ? P.in[15] : P.in[11]) + (size_t)l * 2816 * 1024; s1 = s0;
            dst = (bf16_t*)(ws + OFF_WD + (size_t)j * SZ_WD); ld = 1024; K = 2816; type = 0; ncols = 1024; }
        else if (tile < 9152) { lt = tile - 8448; s0 = s1 = P.in[17]; dst = (bf16_t*)(ws + OFF_WIN); ld = 2728; K = 1024; type = 0; ncols = 2728; gk = P.in[16]; }
        else if (tile < 9408) { lt = tile - 9152; s0 = s1 = P.in[18]; dst = (bf16_t*)(ws + OFF_WOUT); ld = 1024; K = 1024; type = 0; ncols = 1024; }
        else if (tile < 9480) { lt = tile - 9408; s0 = s1 = P.in[24]; dst = (bf16_t*)(ws + OFF_WUQ); ld = 768; K = 384; type = 2; ncols = 768; }
        else if (tile < 9512) { lt = tile - 9480; s0 = s1 = P.in[26]; dst = (bf16_t*)(ws + OFF_WUKVK); ld = 1024; K = 256; type = 3; ncols = 1024; }
        else if (tile < 9544) { lt = tile - 9512; s0 = s1 = P.in[26]; dst = (bf16_t*)(ws + OFF_WUKVV); ld = 1024; K = 256; type = 4; ncols = 1024; }
        else if (tile < 10312) { lt = tile - 9544; s0 = s1 = P.in[31]; dst = (bf16_t*)(ws + OFF_WSCIN); ld = 3072; K = 1024; type = 5; ncols = 3072; gk = P.in[16] + 1024; }
        else { lt = tile - 10312; s0 = s1 = P.in[33]; dst = (bf16_t*)(ws + OFF_WSCOUT); ld = 1024; K = 1024; type = 0; ncols = 1024; }
        const int nkt = K >> 6, ntile = lt / nkt, ktile = lt - ntile * nkt, n0 = ntile * 64, k0 = ktile * 64;
        {
#pragma unroll
            for (int p = 0; p < 2; ++p) {
                const int id = tid + 512 * p, kk = id >> 4, n4 = (id & 15) * 4, n = n0 + n4;
                const int col = map_col(type, n, ncols);
                const float* src = (type == 1 && (n & 255) >= 128) ? s1 : s0;
                f32x4 v = (f32x4){0.f, 0.f, 0.f, 0.f};
                if (col >= 0) v = *(const f32x4*)(src + (size_t)(k0 + kk) * ld + col);
                if (gk) v = v * gk[k0 + kk];
                *(LAS f32x4*)(T + kk * 68 + n4) = v;
            }
        }
        __syncthreads();
        {
            const int nn = tid & 63, k8 = (tid >> 6) * 8;
            float v[8];
#pragma unroll
            for (int k = 0; k < 8; ++k) v[k] = T[(k8 + k) * 68 + nn];
            u32x4 wv; wv.x = cvt_pk_bf16(v[0], v[1]); wv.y = cvt_pk_bf16(v[2], v[3]); wv.z = cvt_pk_bf16(v[4], v[5]); wv.w = cvt_pk_bf16(v[6], v[7]);
            *(u32x4*)(dst + (size_t)(n0 + nn) * K + k0 + k8) = wv;
        }
        __syncthreads();
    }
}
__device__ __forceinline__ int group_tile(int grp, int k) {
    if (grp == 0) return k < 1408 ? k : (k < 2112 ? 5632 + (k - 1408) : 8448 + (k - 2112));
    if (grp == 1) return k < 1408 ? 1408 + k : (k < 2112 ? 6336 + (k - 1408) : (k < 3520 ? 2816 + (k - 2112) : 7040 + (k - 3520)));
    if (grp == 2) return k < 1408 ? 4224 + k : 7744 + (k - 1408);
    if (grp == 3) return 9544 + k;
    if (grp == 4) return k;
    return k < 704 ? 5632 + k : 8448 + (k - 704);
}
__device__ __forceinline__ void convert_group(const Params& P, LAS unsigned char* L, const int tid, int grp, int start, int stride) {
    const int cnt = grp == 0 ? 3208 : (grp == 1 ? 4224 : (grp == 2 ? 2112 : (grp == 3 ? 1024 : (grp == 4 ? 1408 : 1800))));
    for (int k = start; k < cnt; k += stride) convert_tile(P, L, tid, group_tile(grp, k));
}

__device__ __forceinline__ void phase_init(const Params& P, LAS unsigned char* L, const int tid, const int bid) {
    unsigned char* ws = P.ws;
    convert_group(P, L, tid, 4, bid, gridDim.x);
    {
        for (int idx = bid * 512 + tid; idx < N_G1_ITEMS; idx += gridDim.x * 512) ((unsigned*)(ws + OFF_FLG))[idx] = 0u;
        float2* rope = (float2*)(ws + OFF_ROPE);
        for (int idx = bid * 512 + tid; idx < LSEQ * 16; idx += gridDim.x * 512) {
            const int pos = idx >> 4, i = idx & 15;
            const double inv = kRopeInv[i];
            const double a = (double)pos * inv;
            const double kq = __builtin_rint(a * 0.15915494309189535);
            const double r = a - kq * 6.283185307179586476925;
            const double r2 = r * r;
            double s = 1.0 - r2 / 342.0; s = 1.0 - r2 / 272.0 * s; s = 1.0 - r2 / 210.0 * s; s = 1.0 - r2 / 156.0 * s; s = 1.0 - r2 / 110.0 * s;
            s = 1.0 - r2 / 72.0 * s; s = 1.0 - r2 / 42.0 * s; s = 1.0 - r2 / 20.0 * s; s = 1.0 - r2 / 6.0 * s; s = r * s;
            double c = 1.0 - r2 / 380.0; c = 1.0 - r2 / 306.0 * c; c = 1.0 - r2 / 240.0 * c; c = 1.0 - r2 / 182.0 * c; c = 1.0 - r2 / 132.0 * c;
            c = 1.0 - r2 / 90.0 * c; c = 1.0 - r2 / 56.0 * c; c = 1.0 - r2 / 30.0 * c; c = 1.0 - r2 / 12.0 * c; c = 1.0 - r2 / 2.0 * c;
            rope[idx] = make_float2((float)c, (float)s);
        }
    }
    {
        float* X = (float*)(ws + OFF_X); bf16_t* H = (bf16_t*)(ws + OFF_H); float* RSS = (float*)(ws + OFF_SPARE);
        const int wv = bid * 8 + (tid >> 6), nw = gridDim.x * 8, lane = tid & 63;
        float4 nv4[4];
        {
            const int r = wv;
            if (r < MT) {
                const float* src;
                if (r < NP) { const int b = r / LSEQ, pos = r - b * LSEQ; src = pos < 16 ? P.in[7] + (size_t)pos * 1024 : P.in[0] + ((size_t)b * 4096 + (pos - 16)) * 1024; }
                else src = P.in[1] + (size_t)(r - NP) * 1024;
#pragma unroll
                for (int i = 0; i < 4; ++i) nv4[i] = ((const float4*)src)[lane + 64 * i];
            } else {
#pragma unroll
                for (int i = 0; i < 4; ++i) nv4[i] = make_float4(0.f, 0.f, 0.f, 0.f);
            }
        }
        for (int r = wv; r < MP; r += nw) {
            bf16_t* h = H + (size_t)r * 1024;
            float4 v[4];
#pragma unroll
            for (int i = 0; i < 4; ++i) v[i] = nv4[i];
            {
                const int r2 = r + nw;
                if (r2 < MT) {
                    const float* src;
                    if (r2 < NP) { const int b = r2 / LSEQ, pos = r2 - b * LSEQ; src = pos < 16 ? P.in[7] + (size_t)pos * 1024 : P.in[0] + ((size_t)b * 4096 + (pos - 16)) * 1024; }
                    else src = P.in[1] + (size_t)(r2 - NP) * 1024;
#pragma unroll
                    for (int i = 0; i < 4; ++i) nv4[i] = ((const float4*)src)[lane + 64 * i];
                }
            }
            if (r >= MT) {
#pragma unroll
                for (int i = 0; i < 4; ++i) *(u32x2*)(h + 4 * (lane + 64 * i)) = (u32x2){0u, 0u};
                if (lane < 16) RSS[(size_t)r * 16 + lane] = 0.f;
                continue;
            }
            float ss = 0.f;
#pragma unroll
            for (int i = 0; i < 4; ++i) ss += v[i].x * v[i].x + v[i].y * v[i].y + v[i].z * v[i].z + v[i].w * v[i].w;
#pragma unroll
            for (int i = 0; i < 4; ++i) ((float4*)(X + (size_t)r * 1024))[lane + 64 * i] = v[i];
            ss = wsum(ss);
            if (lane < 16) RSS[(size_t)r * 16 + lane] = lane == 0 ? ss : 0.f;
#pragma unroll
            for (int i = 0; i < 4; ++i) { u32x2 w; w.x = cvt_pk_bf16(v[i].x, v[i].y); w.y = cvt_pk_bf16(v[i].z, v[i].w); *(u32x2*)(h + 4 * (lane + 64 * i)) = w; }
        }
    }
}

__device__ __forceinline__ void phase_norm(const Params& P, const float* g, const int tid, const int bid) {
    const float* X = (const float*)(P.ws + OFF_X); bf16_t* H = (bf16_t*)(P.ws + OFF_H);
    const int wv = bid * 8 + (tid >> 6), nw = gridDim.x * 8, lane = tid & 63;
    for (int r = wv; r < MP; r += nw) {
        bf16_t* h = H + (size_t)r * 1024;
        if (r >= MT) {
#pragma unroll
            for (int i = 0; i < 4; ++i) *(u32x2*)(h + 4 * (lane + 64 * i)) = (u32x2){0u, 0u};
            continue;
        }
        float4 v[4]; float ss = 0.f;
#pragma unroll
        for (int i = 0; i < 4; ++i) { v[i] = ((const float4*)(X + (size_t)r * 1024))[lane + 64 * i]; ss += v[i].x * v[i].x + v[i].y * v[i].y + v[i].z * v[i].z + v[i].w * v[i].w; }
        ss = wsum(ss);
        norm_row_store(v, ss, g, h, lane);
    }
}

__device__ __forceinline__ void phase_g1(const Params& P, LAS unsigned char* L, const int tid, const int bid, const int skipm = 0) {
    const int w = tid >> 6, lane = tid & 63, fr = lane & 15, fq = lane >> 4;
    LAS float* XT = (LAS float*)L;
    LAS bf16_t* RAW = (LAS bf16_t*)(L + 98304);
    LAS bf16_t* QB = (LAS bf16_t*)(L + 98304);
    LAS bf16_t* KB = (LAS bf16_t*)(L + 115712);
    LAS float* SG = (LAS float*)(L + 151040);
    LAS float* SEG = SG + 64; LAS float* SBETA = SG + 128; LAS float* SKDEC = SG + 192;
    const bf16_t* HIN = (const bf16_t*)(P.ws + OFF_GU);
    const float* convw = P.in[19];
    unsigned char* dob = (unsigned char*)P.out;
    unsigned* FLG = (unsigned*)(P.ws + OFF_FLG);
    for (int qi = bid - 64; qi < N_G1_ITEMS; qi += gridDim.x - 64) {
        int item;
        if (qi < 32) item = 2080 + qi;
        else { const int q2 = qi - 32, cc_ = q2 >> 5, sh_ = q2 & 31; item = (sh_ >> 2) * 260 + (sh_ & 3) * 65 + cc_; }
        int s, h, c, rb, nv; bool sample;
        if (item < 2080) { s = item / 260; const int r2 = item - s * 260; h = r2 / 65; c = r2 - h * 65; rb = s * LSEQ + 64 * c; nv = LSEQ - 64 * c; if (nv > 64) nv = 64; sample = false; }
        else { const int j = item - 2080; s = 8 + (j >> 2); h = j & 3; c = 0; rb = NP + (s - 8) * 64; nv = 64; sample = true; }
        bf16_t* WKo = (bf16_t*)(dob + DO_WK) + (size_t)item * 8192;
        bf16_t* UTo = (bf16_t*)(dob + DO_UT) + (size_t)item * 8192;
        bf16_t* QDo = (bf16_t*)(dob + DO_QD) + (size_t)item * 8192;
        bf16_t* KTTo = (bf16_t*)(P.ws + OFF_KTT) + (size_t)item * 8192;
        bf16_t* QKo = (bf16_t*)(P.ws + OFF_QK) + (size_t)item * 4096;
        float* GLo = (float*)(P.ws + OFF_GL) + item;
        {
            u32x4 rv[7];
#pragma unroll
            for (int it = 0; it < 7; ++it) {
                const int id = tid + 512 * it;
                u32x4 v = (u32x4){0u, 0u, 0u, 0u};
                if (id < 3216) {
                    const int row = id / 48, ch = id - row * 48, part = ch >> 4, c8 = (ch & 15) * 8, ri = row - 3;
                    const int col = part * 512 + h * 128 + c8;
                    if (ri >= 0) { if (ri < nv) v = *(const u32x4*)(HIN + (size_t)(rb + ri) * HINW + col); }
                    else if (c > 0) v = *(const u32x4*)(HIN + (size_t)(rb + ri) * HINW + col);
                    else if (sample) {
                        const float* sp = P.in[5] + ((size_t)(s - 8) * 3 + (3 + ri)) * 1536 + col;
                        const f32x4 a = *(const f32x4*)sp, b2 = *(const f32x4*)(sp + 4);
                        v.x = cvt_pk_bf16(a[0], a[1]); v.y = cvt_pk_bf16(a[2], a[3]); v.z = cvt_pk_bf16(b2[0], b2[1]); v.w = cvt_pk_bf16(b2[2], b2[3]);
                    }
                }
                rv[it] = v;
            }
#pragma unroll
            for (int it = 0; it < 7; ++it) {
                const int id = tid + 512 * it;
                if (id < 3216) { const int row = id / 48, ch = id - row * 48; *(LAS u32x4*)(RAW + row * 392 + (ch >> 4) * 128 + (ch & 15) * 8) = rv[it]; }
            }
        }
        if (w == 0) {
            const int i = lane; float g = 0.f, beta = 0.f;
            if (i < nv) {
                const float a = bf2f(HIN[(size_t)(rb + i) * HINW + 2048 + h]), bt = bf2f(HIN[(size_t)(rb + i) * HINW + 2052 + h]);
                const float xx = a + P.in[21][h];
                const float ex = __expf(xx);
                const float sp = xx > 20.f ? xx : (ex < 1e-3f ? ex * (1.0f - 0.5f * ex + 0.33333334f * ex * ex) : __logf(1.0f + ex));
                g = -__expf(P.in[20][h]) * sp;
                beta = 1.0f / (1.0f + __expf(-bt));
            }
            float G = g;
#pragma unroll
            for (int o = 1; o < 64; o <<= 1) { const float t = __shfl_up(G, o); if (lane >= o) G += t; }
            const float Gl = __shfl(G, 63);
            SG[i] = G; SEG[i] = __expf(G); SBETA[i] = beta; SKDEC[i] = __expf(Gl - G);
            if (lane == 0) *GLo = Gl;
        }
        __syncthreads();
        if (!(skipm & 2)) for (int task = tid; task < 1536; task += 512) {
            const int seg = task / 384, colg = task - seg * 384, part = colg >> 7, cc = colg & 127;
            const int col = part * 512 + h * 128 + cc;
            const float w0 = convw[col], w1 = convw[1536 + col], w2 = convw[3072 + col], w3 = convw[4608 + col];
            const int i0 = seg * 16;
            LAS bf16_t* rp = RAW + i0 * 392 + colg;
            float xm3 = bf2f(rp[0]), xm2 = bf2f(rp[392]), xm1 = bf2f(rp[784]);
#pragma unroll
            for (int rr = 0; rr < 16; ++rr) {
                const float x = bf2f(rp[(rr + 3) * 392]);
                float y = w0 * xm3 + w1 * xm2 + w2 * xm1 + w3 * x;
                y = (i0 + rr) < nv ? silu_f(y) : 0.f;
                XT[(i0 + rr) * 384 + colg] = y;
                xm3 = xm2; xm2 = xm1; xm1 = x;
            }
        }
        __syncthreads();
        if (!(skipm & 4))
#pragma unroll 2
        for (int rr = 0; rr < 8; ++rr) {
            const int i = w * 8 + rr;
            const float q0 = XT[i * 384 + lane], q1 = XT[i * 384 + 64 + lane], k0 = XT[i * 384 + 128 + lane], k1 = XT[i * 384 + 192 + lane];
            const float v0 = XT[i * 384 + 256 + lane], v1 = XT[i * 384 + 320 + lane];
            const float sq = wsum(q0 * q0 + q1 * q1), sk = wsum(k0 * k0 + k1 * k1);
            const float rq = rsqrtf(sq + EPS) * 0.08838834764831845f, rk = rsqrtf(sk + EPS);
            const float qa = q0 * rq, qb = q1 * rq, ka = k0 * rk, kb = k1 * rk;
            const float eg = SEG[i], beta = SBETA[i];
            QB[i * 136 + lane] = f2bf(qa); QB[i * 136 + 64 + lane] = f2bf(qb);
            KB[i * 136 + lane] = f2bf(ka); KB[i * 136 + 64 + lane] = f2bf(kb);
            QDo[i * 128 + lane] = f2bf(qa * eg); QDo[i * 128 + 64 + lane] = f2bf(qb * eg);
            XT[i * 384 + 128 + lane] = beta * eg * ka; XT[i * 384 + 192 + lane] = beta * eg * kb;
            XT[i * 384 + 256 + lane] = beta * v0; XT[i * 384 + 320 + lane] = beta * v1;
        }
        __syncthreads();
        {
            const int d = tid & 127;
#pragma unroll
            for (int t2 = 0; t2 < 2; ++t2) {
                const int i8 = (tid >> 7) + 4 * t2;
                float kv[8];
#pragma unroll
                for (int k = 0; k < 8; ++k) kv[k] = bf2f(KB[(8 * i8 + k) * 136 + d]) * SKDEC[8 * i8 + k];
                u32x4 wv; wv.x = cvt_pk_bf16(kv[0], kv[1]); wv.y = cvt_pk_bf16(kv[2], kv[3]); wv.z = cvt_pk_bf16(kv[4], kv[5]); wv.w = cvt_pk_bf16(kv[6], kv[7]);
                *(u32x4*)(KTTo + d * 64 + 8 * i8) = wv;
            }
        }
        {
            const int mi = w >> 1;
#pragma unroll
            for (int t2 = 0; t2 < 2; ++t2) {
                const int nj = 2 * (w & 1) + t2;
                f32x4 akk = {0.f, 0.f, 0.f, 0.f}, aqk = {0.f, 0.f, 0.f, 0.f};
#pragma unroll
                for (int ks = 0; ks < 4; ++ks) {
                    const bf16x8 ak = *(const LAS bf16x8*)(KB + (16 * mi + fr) * 136 + 32 * ks + 8 * fq);
                    const bf16x8 aq = *(const LAS bf16x8*)(QB + (16 * mi + fr) * 136 + 32 * ks + 8 * fq);
                    const bf16x8 bk = *(const LAS bf16x8*)(KB + (16 * nj + fr) * 136 + 32 * ks + 8 * fq);
                    akk = mfma16(ak, bk, akk); aqk = mfma16(aq, bk, aqk);
                }
                const int colj = 16 * nj + fr; const float Gj = SG[colj];
#pragma unroll
                for (int j = 0; j < 4; ++j) {
                    const int rowi = 16 * mi + 4 * fq + j; const float Gi = SG[rowi];
                    const float dec = __expf(fminf(Gi - Gj, 0.f));
                    if (colj < rowi) XT[rowi * 384 + colj] = SBETA[rowi] * akk[j] * dec;
                    QKo[rowi * 64 + colj] = f2bf(colj <= rowi ? aqk[j] * dec : 0.f);
                }
            }
        }
        __syncthreads();
        if (tid < 256 && !(skipm & 1)) {
            const int cidx = 128 + tid;
            float sol[64];
            LAS float* XA = XT; LAS float* XB = XT + 32 * 384;
            asm volatile("" : "+v"(XA)); asm volatile("" : "+v"(XB));
#pragma unroll
            for (int i = 0; i < 64; ++i) {
                LAS float* rowp = i < 32 ? XA + i * 384 : XB + (i - 32) * 384;
                float a0 = rowp[cidx], a1 = 0.f;
                const int arow = __builtin_bit_cast(int, rowp[lane]);
#pragma unroll
                for (int j4 = 0; j4 < (i + 3) / 4; ++j4) {
                    float aj[4];
#pragma unroll
                    for (int k = 0; k < 4; ++k) aj[k] = __builtin_bit_cast(float, __builtin_amdgcn_readlane(arow, (4 * j4 + k) & 63));
#pragma unroll
                    for (int k = 0; k < 4; ++k) { const int j = 4 * j4 + k; if (j < i) { if (j & 1) a1 -= aj[k] * sol[j]; else a0 -= aj[k] * sol[j]; } }
                }
                sol[i] = a0 + a1;
            }
            if (tid < 128) {
#pragma unroll
                for (int i = 0; i < 64; ++i) WKo[i * 128 + tid] = f2bf(sol[i]);
            } else {
                const int e = tid - 128;
#pragma unroll
                for (int i8 = 0; i8 < 8; ++i8) {
                    u32x4 wv; wv.x = cvt_pk_bf16(sol[8 * i8], sol[8 * i8 + 1]); wv.y = cvt_pk_bf16(sol[8 * i8 + 2], sol[8 * i8 + 3]);
                    wv.z = cvt_pk_bf16(sol[8 * i8 + 4], sol[8 * i8 + 5]); wv.w = cvt_pk_bf16(sol[8 * i8 + 6], sol[8 * i8 + 7]);
                    *(u32x4*)(UTo + e * 64 + 8 * i8) = wv;
                }
            }
        }
        asm volatile("s_waitcnt vmcnt(0)" ::: "memory");
        __syncthreads();
        if (tid == 0 && !(skipm & 8)) __hip_atomic_store(FLG + item, 1u, __ATOMIC_RELEASE, __HIP_MEMORY_SCOPE_AGENT);
    }
}

struct ScanA { bf16x8 wk[4], qd[4]; bf16x4 u[4]; };
struct ScanB { bf16x8 qk[2], kt[2]; };
__device__ __forceinline__ void scan_load_a(ScanA& F, const Params& P, int item, int cb, int eh, int fr, int fq) {
    const unsigned char* dob = (const unsigned char*)P.out;
    const bf16_t* WK = (const bf16_t*)(dob + DO_WK) + (size_t)item * 8192;
    const bf16_t* QD = (const bf16_t*)(dob + DO_QD) + (size_t)item * 8192;
    const bf16_t* UT = (const bf16_t*)(dob + DO_UT) + (size_t)item * 8192;
#pragma unroll
    for (int eb = 0; eb < 4; ++eb) F.u[eb] = *(const bf16x4*)(UT + (16 * (4 * eh + eb) + fr) * 64 + 16 * cb + 4 * fq);
#pragma unroll
    for (int ks = 0; ks < 4; ++ks) { F.wk[ks] = *(const bf16x8*)(WK + (16 * cb + fr) * 128 + 32 * ks + 8 * fq); F.qd[ks] = *(const bf16x8*)(QD + (16 * cb + fr) * 128 + 32 * ks + 8 * fq); }
}
__device__ __forceinline__ void scan_load_b(ScanB& F, const Params& P, int item, int cb, int eh, int w, int fr, int fq) {
    const bf16_t* KTT = (const bf16_t*)(P.ws + OFF_KTT) + (size_t)item * 8192;
    const bf16_t* QK = (const bf16_t*)(P.ws + OFF_QK) + (size_t)item * 4096;
#pragma unroll
    for (int ks = 0; ks < 2; ++ks) { F.qk[ks] = *(const bf16x8*)(QK + (16 * cb + fr) * 64 + 32 * ks + 8 * fq); F.kt[ks] = *(const bf16x8*)(KTT + (16 * w + fr) * 64 + 32 * ks + 8 * fq); }
}

__device__ __forceinline__ int scan_wait(const unsigned* FLG, int first, int maxcount, int w, int lane, LAS int* word) {
    if (w == 0) {
        int lead;
        for (;;) {
            unsigned f = 0u;
            if (lane < maxcount) f = __hip_atomic_load(FLG + first + lane, __ATOMIC_RELAXED, __HIP_MEMORY_SCOPE_AGENT);
            const unsigned long long m = __ballot(f != 0u);
            lead = __builtin_ctzll(~m);
            if (lead >= 1) break;
            __builtin_amdgcn_s_sleep(4);
        }
        __builtin_amdgcn_fence(__ATOMIC_ACQUIRE, "agent");
        if (lane == 0) *word = lead;
    }
    __syncthreads();
    return *word;
}
constexpr int SCAN_WIN = 16;
__device__ __forceinline__ void phase_scan(const Params& P, LAS unsigned char* L, const int tid, const int bid) {
    const int w = tid >> 6, lane = tid & 63, fr = lane & 15, fq = lane >> 4;
    const unsigned* FLG = (const unsigned*)(P.ws + OFF_FLG);
    const int cb = w & 3, eh = w >> 2;
    LAS bf16_t* WT = (LAS bf16_t*)(L + 69632);
    LAS float* SSB = (LAS float*)(L + 88064);
    const bf16_t* HIN = (const bf16_t*)(P.ws + OFF_GU);
    bf16_t* O = (bf16_t*)(P.ws + OFF_H);
    for (int sh = bid; sh < 64; sh += gridDim.x) {
        const int s = sh >> 2, h = sh & 3;
        const bool sample = s >= 8;
        const int nch = sample ? 1 : 65;
        const int item0 = sample ? 2080 + (s - 8) * 4 + h : s * 260 + h * 65;
        const int rb0 = sample ? NP + (s - 8) * 64 : s * LSEQ;
        f32x4 sacc[8];
        if (sample) {
            const float* S0 = P.in[4] + ((size_t)(s - 8) * 4 + h) * 16384;
#pragma unroll
            for (int eb = 0; eb < 8; ++eb)
#pragma unroll
                for (int j = 0; j < 4; ++j) sacc[eb][j] = S0[(16 * w + 4 * fq + j) * 128 + 16 * eb + fr];
        } else {
#pragma unroll
            for (int eb = 0; eb < 8; ++eb) sacc[eb] = (f32x4){0.f, 0.f, 0.f, 0.f};
        }
        __syncthreads();
        {
            LAS bf16_t* St = (LAS bf16_t*)L;
#pragma unroll
            for (int eb = 0; eb < 8; ++eb) { u32x2 wv; wv.x = cvt_pk_bf16(sacc[eb][0], sacc[eb][1]); wv.y = cvt_pk_bf16(sacc[eb][2], sacc[eb][3]);
                *(LAS u32x2*)(St + (16 * eb + fr) * 136 + 16 * w + 4 * fq) = wv; }
        }
        LAS int* wword = (LAS int*)(L + 88064);
        int ready = scan_wait(FLG, item0, nch < SCAN_WIN ? nch : SCAN_WIN, w, lane, wword) - 1;
        ScanA F; scan_load_a(F, P, item0, cb, eh, fr, fq);
        __syncthreads();
#pragma unroll 1
        for (int n = 0; n < nch; ++n) {
            const int cur = n & 1;
            LAS bf16_t* Sc = (LAS bf16_t*)(L + cur * 34816);
            LAS bf16_t* Sn = (LAS bf16_t*)(L + (cur ^ 1) * 34816);
            const int rb = rb0 + 64 * n; int nv = sample ? 64 : LSEQ - 64 * n; if (nv > 64) nv = 64;
            if (n + 1 < nch && n + 1 > ready) { const int cnt = (nch - (n + 1)) < SCAN_WIN ? (nch - (n + 1)) : SCAN_WIN; ready = n + scan_wait(FLG, item0 + n + 1, cnt, w, lane, wword); }
            const float egl = __expf(((const float*)(P.ws + OFF_GL))[item0 + n]);
            const int orow = tid >> 3, oseg = tid & 7;
            ScanB G; scan_load_b(G, P, item0 + n, cb, eh, w, fr, fq);
            ScanA Fn;
            if (n + 1 < nch) scan_load_a(Fn, P, item0 + n + 1, cb, eh, fr, fq); else Fn = F;
            f32x4 wacc[4], oacc[4];
#pragma unroll
            for (int eb = 0; eb < 4; ++eb) { wacc[eb] = (f32x4){0.f, 0.f, 0.f, 0.f}; oacc[eb] = (f32x4){0.f, 0.f, 0.f, 0.f}; }
#pragma unroll
            for (int ks = 0; ks < 4; ++ks)
#pragma unroll
                for (int eb = 0; eb < 4; ++eb) {
                    const bf16x8 b = *(const LAS bf16x8*)(Sc + (16 * (4 * eh + eb) + fr) * 136 + 32 * ks + 8 * fq);
                    wacc[eb] = mfma16(F.wk[ks], b, wacc[eb]); oacc[eb] = mfma16(F.qd[ks], b, oacc[eb]);
                }
#pragma unroll
            for (int eb = 0; eb < 4; ++eb) {
                const float w0 = bf2f((bf16_t)F.u[eb][0]) - wacc[eb][0], w1 = bf2f((bf16_t)F.u[eb][1]) - wacc[eb][1];
                const float w2 = bf2f((bf16_t)F.u[eb][2]) - wacc[eb][2], w3 = bf2f((bf16_t)F.u[eb][3]) - wacc[eb][3];
                u32x2 wv; wv.x = cvt_pk_bf16(w0, w1); wv.y = cvt_pk_bf16(w2, w3);
                *(LAS u32x2*)(WT + (16 * (4 * eh + eb) + fr) * 72 + 16 * cb + 4 * fq) = wv;
            }
            __syncthreads();
            u32x4 zr0 = (u32x4){0u, 0u, 0u, 0u}, zr1 = zr0;
            if (orow < nv) { const bf16_t* zp = HIN + (size_t)(rb + orow) * HINW + 1536 + h * 128 + 16 * oseg; zr0 = *(const u32x4*)zp; zr1 = *(const u32x4*)(zp + 8); }
#pragma unroll
            for (int ks = 0; ks < 2; ++ks)
#pragma unroll
                for (int eb = 0; eb < 4; ++eb) {
                    const bf16x8 b = *(const LAS bf16x8*)(WT + (16 * (4 * eh + eb) + fr) * 72 + 32 * ks + 8 * fq);
                    oacc[eb] = mfma16(G.qk[ks], b, oacc[eb]);
                }
#pragma unroll
            for (int eb = 0; eb < 8; ++eb) {
                sacc[eb] = sacc[eb] * egl;
#pragma unroll
                for (int ks = 0; ks < 2; ++ks) {
                    const bf16x8 b = *(const LAS bf16x8*)(WT + (16 * eb + fr) * 72 + 32 * ks + 8 * fq);
                    sacc[eb] = mfma16(G.kt[ks], b, sacc[eb]);
                }
                u32x2 wv; wv.x = cvt_pk_bf16(sacc[eb][0], sacc[eb][1]); wv.y = cvt_pk_bf16(sacc[eb][2], sacc[eb][3]);
                *(LAS u32x2*)(Sn + (16 * eb + fr) * 136 + 16 * w + 4 * fq) = wv;
            }
            {
                LAS float* OT = (LAS float*)(L + 88576);
#pragma unroll
                for (int eb = 0; eb < 4; ++eb)
#pragma unroll
                    for (int j = 0; j < 4; ++j) OT[(16 * cb + 4 * fq + j) * 132 + 16 * (4 * eh + eb) + fr] = oacc[eb][j];
            }
            __syncthreads();
            {
                const LAS float* OT = (const LAS float*)(L + 88576) + orow * 132 + 16 * oseg;
                f32x4 ov[4];
#pragma unroll
                for (int k = 0; k < 4; ++k) ov[k] = *(const LAS f32x4*)(OT + 4 * k);
                float ssq = 0.f;
#pragma unroll
                for (int k = 0; k < 4; ++k) ssq += ov[k][0] * ov[k][0] + ov[k][1] * ov[k][1] + ov[k][2] * ov[k][2] + ov[k][3] * ov[k][3];
                ssq += __shfl_xor(ssq, 1); ssq += __shfl_xor(ssq, 2); ssq += __shfl_xor(ssq, 4);
                const float r = rsqrtf(ssq * (1.0f / 128.0f) + EPS);
                if (orow < nv) {
                    const float* gn = P.in[22] + 16 * oseg;
                    unsigned zz[8] = {zr0.x, zr0.y, zr0.z, zr0.w, zr1.x, zr1.y, zr1.z, zr1.w};
                    unsigned ow[8];
#pragma unroll
                    for (int k = 0; k < 8; ++k) {
                        const float z0 = __uint_as_float(zz[k] << 16), z1 = __uint_as_float(zz[k] & 0xffff0000u);
                        const float o0 = ov[k >> 1][(k & 1) * 2] * r * gn[2 * k] * silu_f(z0), o1 = ov[k >> 1][(k & 1) * 2 + 1] * r * gn[2 * k + 1] * silu_f(z1);
                        ow[k] = cvt_pk_bf16(o0, o1);
                    }
                    bf16_t* op = O + (size_t)(rb + orow) * 1024 + h * 128 + 16 * oseg;
                    *(u32x4*)op = (u32x4){ow[0], ow[1], ow[2], ow[3]}; *(u32x4*)(op + 8) = (u32x4){ow[4], ow[5], ow[6], ow[7]};
                }
            }
            F = Fn;
        }
        float* So = P.out + (sample ? OFF_SS + ((size_t)(s - 8) * 4 + h) * 16384 : OFF_PS + ((size_t)s * 4 + h) * 16384);
#pragma unroll
        for (int eb = 0; eb < 8; ++eb)
#pragma unroll
            for (int j = 0; j < 4; ++j) So[(16 * w + 4 * fq + j) * 128 + 16 * eb + fr] = sacc[eb][j];
    }
}

__device__ __forceinline__ void phase_mlaprep(const Params& P, const int tid, const int bid) {
    const int lane = tid & 63;
    const bf16_t* HIN = (const bf16_t*)(P.ws + OFF_GU);
    bf16_t* CQ = (bf16_t*)(P.ws + OFF_CQ); bf16_t* CKVA = (bf16_t*)(P.ws + OFF_CKVA); bf16_t* KRA = (bf16_t*)(P.ws + OFF_KRA);
    const float2* rope = (const float2*)(P.ws + OFF_ROPE);
    const int wv = bid * 8 + (tid >> 6), nw = gridDim.x * 8;
    constexpr int T0 = MT, T1 = T0 + 8192, T2 = T1 + (MKP - MK), T3 = T2 + (MP - MT), T4 = T3 + 48;
    for (int task = wv; task < T4; task += nw) {
        if (task < T0) {
            const int r = task;
            const bf16_t* hr = HIN + (size_t)r * HINW;
            int pos, keyrow; float* ockv; float* okr;
            if (r < NP) { pos = r % LSEQ; keyrow = r; ockv = P.out + OFF_PCKV + (size_t)r * 256; okr = P.out + OFF_PKR + (size_t)r * 32; }
            else { const int q = r - NP, b = q >> 6, t = q & 63; pos = 1024 + t; keyrow = NP + b * 1088 + 1024 + t; ockv = P.out + OFF_SCKV + (size_t)q * 256; okr = P.out + OFF_SKR + (size_t)q * 32; }
            {
                float v[6]; float ss = 0.f;
#pragma unroll
                for (int k = 0; k < 6; ++k) { v[k] = bf2f(hr[2056 + lane + 64 * k]); ss += v[k] * v[k]; }
                ss = wsum(ss); const float rs = rsqrtf(ss * (1.0f / 384.0f) + EPS);
#pragma unroll
                for (int k = 0; k < 6; ++k) CQ[(size_t)r * 384 + lane + 64 * k] = f2bf(v[k] * rs * P.in[23][lane + 64 * k]);
            }
            {
                float v[4]; float ss = 0.f;
#pragma unroll
                for (int k = 0; k < 4; ++k) { v[k] = bf2f(hr[2440 + lane + 64 * k]); ss += v[k] * v[k]; }
                ss = wsum(ss); const float rs = rsqrtf(ss * (1.0f / 256.0f) + EPS);
#pragma unroll
                for (int k = 0; k < 4; ++k) { const float y = v[k] * rs * P.in[25][lane + 64 * k]; ockv[lane + 64 * k] = y; CKVA[(size_t)keyrow * 256 + lane + 64 * k] = f2bf(y); }
            }
            {
                const float v = lane < 32 ? bf2f(hr[2696 + lane]) : 0.f;
                const float ss = wsum(v * v); const float rs = rsqrtf(ss * (1.0f / 32.0f) + EPS);
                const float y = lane < 32 ? v * rs * P.in[30][lane] : 0.f;
                const float pr = __shfl_xor(y, 16);
                const float2 cs = rope[pos * 16 + (lane & 15)];
                const float o = (lane & 16) ? (y * cs.x + pr * cs.y) : (y * cs.x - pr * cs.y);
                if (lane < 32) { okr[lane] = o; KRA[(size_t)keyrow * 32 + lane] = f2bf(o); }
            }
        } else if (task < T1) {
            const int q = task - T0, b = q >> 10, j = q & 1023, keyrow = NP + b * 1088 + j;
            const float* sc = P.in[2] + ((size_t)b * 1024 + j) * 256;
#pragma unroll
            for (int k = 0; k < 4; ++k) CKVA[(size_t)keyrow * 256 + lane + 64 * k] = f2bf(sc[lane + 64 * k]);
            if (lane < 32) KRA[(size_t)keyrow * 32 + lane] = f2bf(P.in[3][((size_t)b * 1024 + j) * 32 + lane]);
        } else if (task < T2) {
            const int keyrow = MK + (task - T1);
#pragma unroll
            for (int k = 0; k < 4; ++k) CKVA[(size_t)keyrow * 256 + lane + 64 * k] = 0;
            if (lane < 32) KRA[(size_t)keyrow * 32 + lane] = 0;
        } else if (task < T3) {
            const int r = MT + (task - T2);
#pragma unroll
            for (int k = 0; k < 6; ++k) CQ[(size_t)r * 384 + lane + 64 * k] = 0;
        } else {
            const int k3 = task - T3, s = k3 / 3, i = k3 - 3 * s;
            const int srow = s < 8 ? s * LSEQ + (LSEQ - 3) + i : NP + (s - 8) * 64 + 61 + i;
            float* dst = s < 8 ? P.out + OFF_PCONV + ((size_t)s * 3 + i) * 1536 : P.out + OFF_SCONV + ((size_t)(s - 8) * 3 + i) * 1536;
            for (int k = 0; k < 24; ++k) dst[lane + 64 * k] = bf2f(HIN[(size_t)srow * HINW + lane + 64 * k]);
        }
    }
}

__device__ __forceinline__ void phase_attn(const Params& P, LAS unsigned char* L, const int tid, const int bid) {
    const int w = tid >> 6, lane = tid & 63, fr = lane & 15, fq = lane >> 4;
    const bf16_t* Q = (const bf16_t*)(P.ws + OFF_Q); const bf16_t* KN = (const bf16_t*)(P.ws + OFF_KN);
    const bf16_t* KRA = (const bf16_t*)(P.ws + OFF_KRA); const bf16_t* VT = (const bf16_t*)(P.ws + OFF_VT);
    bf16_t* O = (bf16_t*)(P.ws + OFF_H);
    constexpr int BUFB = 22528;
    const int krow = tid >> 3, kch = tid & 7;
    const int rrow = (tid & 255) >> 2, rch = tid & 3;
    const int G_ = (int)gridDim.x;
    for (int rnd = 0; rnd * G_ < 1088 + 64; ++rnd) {
        const int idx = rnd * G_ + ((rnd & 1) ? G_ - 1 - bid : bid);
        if (idx >= 1088 + 64) continue;
        const int item = idx < 64 ? 1088 + idx : idx - 64;
        int b, head, rowq, kb, kendb; int kend[2]; bool act[2];
        if (item < 1088) {
            const int t = 16 - item / 64, bh = item & 63; b = bh >> 3; head = bh & 7;
            const int q0 = 256 * t + 32 * w; rowq = b * LSEQ + q0; kb = b * LSEQ;
#pragma unroll
            for (int g = 0; g < 2; ++g) { act[g] = (q0 + 16 * g) < LSEQ; kend[g] = 16 + 64 * (((q0 + 16 * g - 16) >> 6) + 1); }
            int lastq = 256 * t + 255; if (lastq > LSEQ - 1) lastq = LSEQ - 1;
            kendb = 16 + 64 * (((lastq - 16) >> 6) + 1);
        } else {
            const int j = item - 1088; b = j >> 3; head = j & 7; rowq = NP + b * 64 + 32 * w; kb = NP + b * 1088; kendb = 1088;
            act[0] = act[1] = w < 2; kend[0] = kend[1] = 1088;
        }
        const int ntile = (kendb + 63) >> 6;
        bf16x8 qf[2][3];
#pragma unroll
        for (int g = 0; g < 2; ++g) {
            if (act[g]) {
                const bf16_t* qrow = Q + (size_t)(rowq + 16 * g + fr) * 768;
                qf[g][0] = *(const bf16x8*)(qrow + head * 64 + 8 * fq); qf[g][1] = *(const bf16x8*)(qrow + head * 64 + 32 + 8 * fq); qf[g][2] = *(const bf16x8*)(qrow + 512 + head * 32 + 8 * fq);
            } else { qf[g][0] = qf[g][1] = qf[g][2] = (bf16x8){0, 0, 0, 0, 0, 0, 0, 0}; }
        }
        f32x4 o[2][4];
#pragma unroll
        for (int g = 0; g < 2; ++g)
#pragma unroll
            for (int d = 0; d < 4; ++d) o[g][d] = (f32x4){0.f, 0.f, 0.f, 0.f};
        float mrun[2] = {-1e30f, -1e30f}, lrun[2] = {0.f, 0.f};
        const bf16_t* knp = KN + (size_t)(kb + krow) * 512 + head * 64 + 8 * kch;
        const bf16_t* krp = KRA + (size_t)(kb + rrow) * 32 + 8 * rch;
        const bf16_t* vtp = VT + (size_t)(head * 64 + krow) * MKP + kb + 8 * kch;
        u32x4 rk = *(const u32x4*)knp, rv = *(const u32x4*)vtp, rr = (u32x4){0u, 0u, 0u, 0u};
        if (tid < 256) rr = *(const u32x4*)krp;
        __syncthreads();
        *(LAS u32x4*)(L + (krow * 104 + 8 * kch) * 2) = rk;
        *(LAS u32x4*)(L + 13312 + (krow * 72 + 8 * kch) * 2) = rv;
        if (tid < 256) *(LAS u32x4*)(L + (rrow * 104 + 64 + 8 * rch) * 2) = rr;
        __syncthreads();
#pragma unroll 1
        for (int kt = 0; kt < ntile; ++kt) {
            const int cur = kt & 1;
            const bool more = kt + 1 < ntile;
            if (more) {
                rk = *(const u32x4*)(knp + (size_t)(kt + 1) * 64 * 512);
                rv = *(const u32x4*)(vtp + (kt + 1) * 64);
                if (tid < 256) rr = *(const u32x4*)(krp + (size_t)(kt + 1) * 64 * 32);
            }
            const bool do0 = act[0] && 64 * kt < kend[0], do1 = act[1] && 64 * kt < kend[1];
            if (do0 || do1) {
                LAS bf16_t* Kt = (LAS bf16_t*)(L + cur * BUFB);
                LAS bf16_t* Vt = (LAS bf16_t*)(L + cur * BUFB + 13312);
                f32x4 sc[2][4];
#pragma unroll
                for (int i = 0; i < 4; ++i) {
                    sc[0][i] = (f32x4){0.f, 0.f, 0.f, 0.f}; sc[1][i] = (f32x4){0.f, 0.f, 0.f, 0.f};
#pragma unroll
                    for (int ks = 0; ks < 3; ++ks) {
                        const bf16x8 a = *(const LAS bf16x8*)(Kt + (16 * i + fr) * 104 + 32 * ks + 8 * fq);
                        sc[0][i] = mfma16(a, qf[0][ks], sc[0][i]);
                        sc[1][i] = mfma16(a, qf[1][ks], sc[1][i]);
                    }
                }
                bf16x8 pf[2][2];
#pragma unroll
                for (int g = 0; g < 2; ++g) {
                    if (64 * kt + 64 > kend[g]) {
#pragma unroll
                        for (int i = 0; i < 4; ++i)
#pragma unroll
                            for (int j = 0; j < 4; ++j) if (64 * kt + 16 * i + 4 * fq + j >= kend[g]) sc[g][i][j] = -1e30f;
                    }
                    float mx = -1e30f;
#pragma unroll
                    for (int i = 0; i < 4; ++i) mx = fmaxf(mx, fmaxf(fmaxf(sc[g][i][0], sc[g][i][1]), fmaxf(sc[g][i][2], sc[g][i][3])));
                    mx = fmaxf(mx, __shfl_xor(mx, 16)); mx = fmaxf(mx, __shfl_xor(mx, 32));
                    const float mn = fmaxf(mrun[g], mx);
                    const float alpha = __builtin_amdgcn_exp2f(mrun[g] - mn);
                    mrun[g] = mn;
                    float ls = 0.f;
#pragma unroll
                    for (int i = 0; i < 4; ++i)
#pragma unroll
                        for (int j = 0; j < 4; ++j) { const float p = __builtin_amdgcn_exp2f(sc[g][i][j] - mn); sc[g][i][j] = p; ls += p; }
                    lrun[g] = lrun[g] * alpha + ls;
#pragma unroll
                    for (int d = 0; d < 4; ++d) o[g][d] = o[g][d] * alpha;
#pragma unroll
                    for (int s2 = 0; s2 < 2; ++s2) {
                        u32x4 pw; pw.x = cvt_pk_bf16(sc[g][2 * s2][0], sc[g][2 * s2][1]); pw.y = cvt_pk_bf16(sc[g][2 * s2][2], sc[g][2 * s2][3]);
                        pw.z = cvt_pk_bf16(sc[g][2 * s2 + 1][0], sc[g][2 * s2 + 1][1]); pw.w = cvt_pk_bf16(sc[g][2 * s2 + 1][2], sc[g][2 * s2 + 1][3]);
                        pf[g][s2] = __builtin_bit_cast(bf16x8, pw);
                    }
                }
#pragma unroll
                for (int d = 0; d < 4; ++d)
#pragma unroll
                    for (int s2 = 0; s2 < 2; ++s2) {
                        const u32x2 lo = *(const LAS u32x2*)(Vt + (16 * d + fr) * 72 + 32 * s2 + 4 * fq);
                        const u32x2 hi = *(const LAS u32x2*)(Vt + (16 * d + fr) * 72 + 32 * s2 + 16 + 4 * fq);
                        u32x4 av; av.x = lo.x; av.y = lo.y; av.z = hi.x; av.w = hi.y;
                        const bf16x8 avb = __builtin_bit_cast(bf16x8, av);
                        o[0][d] = mfma16(avb, pf[0][s2], o[0][d]);
                        o[1][d] = mfma16(avb, pf[1][s2], o[1][d]);
                    }
            }
            if (more) {
                LAS unsigned char* nb = L + (cur ^ 1) * BUFB;
                *(LAS u32x4*)(nb + (krow * 104 + 8 * kch) * 2) = rk;
                *(LAS u32x4*)(nb + 13312 + (krow * 72 + 8 * kch) * 2) = rv;
                if (tid < 256) *(LAS u32x4*)(nb + (rrow * 104 + 64 + 8 * rch) * 2) = rr;
            }
            __syncthreads();
        }
#pragma unroll
        for (int g = 0; g < 2; ++g) {
            if (act[g]) {
                float lt = lrun[g]; lt += __shfl_xor(lt, 16); lt += __shfl_xor(lt, 32);
                const float inv = 1.0f / lt;
#pragma unroll
                for (int d = 0; d < 4; ++d) {
                    u32x2 wv; wv.x = cvt_pk_bf16(o[g][d][0] * inv, o[g][d][1] * inv); wv.y = cvt_pk_bf16(o[g][d][2] * inv, o[g][d][3] * inv);
                    *(u32x2*)(O + (size_t)(rowq + 16 * g + fr) * 1024 + 512 + head * 64 + 16 * d + 4 * fq) = wv;
                }
            }
        }
    }
}

__device__ __forceinline__ void phase_sconv(const Params& P, const int tid, const int bid) {
    const int lane = tid & 63;
    const bf16_t* Pb = (const bf16_t*)(P.ws + OFF_P); const bf16_t* BG = (const bf16_t*)(P.ws + OFF_BG);
    bf16_t* A2 = (bf16_t*)(P.ws + OFF_H);
    const float* cw = P.in[32];
    const int wv = bid * 8 + (tid >> 6), nw = gridDim.x * 8;
    const int c0 = lane * 16;
    const int R = (MP + nw - 1) / nw, rbeg = wv * R, rend = (rbeg + R) < MP ? (rbeg + R) : MP;
    float w0[16], w1[16], w2[16];
#pragma unroll
    for (int k = 0; k < 16; ++k) { w0[k] = cw[c0 + k]; w1[k] = cw[1024 + c0 + k]; w2[k] = cw[2048 + c0 + k]; }
    float p0[16], p1[16];
#pragma unroll
    for (int k = 0; k < 16; ++k) { p0[k] = 0.f; p1[k] = 0.f; }
    bf16x8 nx0 = (bf16x8){0, 0, 0, 0, 0, 0, 0, 0}, nx1 = nx0, ng0 = nx0, ng1 = nx0;
    if (rbeg < rend && rbeg < MT) { nx0 = *(const bf16x8*)(Pb + (size_t)rbeg * 1024 + c0); nx1 = *(const bf16x8*)(Pb + (size_t)rbeg * 1024 + c0 + 8);
                                    ng0 = *(const bf16x8*)(BG + (size_t)rbeg * 1024 + c0); ng1 = *(const bf16x8*)(BG + (size_t)rbeg * 1024 + c0 + 8); }
    for (int r = rbeg; r < rend; ++r) {
        bf16_t* a2 = A2 + (size_t)r * 1024 + c0;
        const bf16x8 x0 = nx0, x1 = nx1, g0 = ng0, g1 = ng1;
        if (r + 1 < rend && r + 1 < MT) { nx0 = *(const bf16x8*)(Pb + (size_t)(r + 1) * 1024 + c0); nx1 = *(const bf16x8*)(Pb + (size_t)(r + 1) * 1024 + c0 + 8);
                                          ng0 = *(const bf16x8*)(BG + (size_t)(r + 1) * 1024 + c0); ng1 = *(const bf16x8*)(BG + (size_t)(r + 1) * 1024 + c0 + 8); }
        if (r >= MT) { *(u32x4*)a2 = (u32x4){0u, 0u, 0u, 0u}; *(u32x4*)(a2 + 8) = (u32x4){0u, 0u, 0u, 0u}; continue; }
        int t, b; const bool sample = r >= NP;
        if (!sample) { b = r / LSEQ; t = r - b * LSEQ; } else { const int q = r - NP; b = q >> 6; t = q & 63; }
        float p2[16], bg[16];
        {
#pragma unroll
            for (int k = 0; k < 8; ++k) { p2[k] = bf2f((bf16_t)x0[k]); p2[8 + k] = bf2f((bf16_t)x1[k]); bg[k] = bf2f((bf16_t)g0[k]); bg[8 + k] = bf2f((bf16_t)g1[k]); }
        }
        if (r == rbeg || t < 2) {
            if (t >= 1) {
                const bf16x8 x0 = *(const bf16x8*)(Pb + (size_t)(r - 1) * 1024 + c0), x1 = *(const bf16x8*)(Pb + (size_t)(r - 1) * 1024 + c0 + 8);
#pragma unroll
                for (int k = 0; k < 8; ++k) { p1[k] = bf2f((bf16_t)x0[k]); p1[8 + k] = bf2f((bf16_t)x1[k]); }
            } else {
#pragma unroll
                for (int k = 0; k < 16; ++k) p1[k] = sample ? P.in[6][((size_t)b * 2 + 1) * 1024 + c0 + k] : 0.f;
            }
            if (t >= 2) {
                const bf16x8 x0 = *(const bf16x8*)(Pb + (size_t)(r - 2) * 1024 + c0), x1 = *(const bf16x8*)(Pb + (size_t)(r - 2) * 1024 + c0 + 8);
#pragma unroll
                for (int k = 0; k < 8; ++k) { p0[k] = bf2f((bf16_t)x0[k]); p0[8 + k] = bf2f((bf16_t)x1[k]); }
            } else {
#pragma unroll
                for (int k = 0; k < 16; ++k) p0[k] = sample ? P.in[6][((size_t)b * 2 + t) * 1024 + c0 + k] : 0.f;
            }
        }
        float y[16];
#pragma unroll
        for (int k = 0; k < 16; ++k) y[k] = bg[k] * (w0[k] * p0[k] + w1[k] * p1[k] + w2[k] * p2[k]);
        u32x4 v0, v1;
        v0.x = cvt_pk_bf16(y[0], y[1]); v0.y = cvt_pk_bf16(y[2], y[3]); v0.z = cvt_pk_bf16(y[4], y[5]); v0.w = cvt_pk_bf16(y[6], y[7]);
        v1.x = cvt_pk_bf16(y[8], y[9]); v1.y = cvt_pk_bf16(y[10], y[11]); v1.z = cvt_pk_bf16(y[12], y[13]); v1.w = cvt_pk_bf16(y[14], y[15]);
        *(u32x4*)a2 = v0; *(u32x4*)(a2 + 8) = v1;
        const int tl = sample ? 64 : LSEQ;
        if (t >= tl - 2) {
            float* dst = P.out + (sample ? OFF_SSC : OFF_PSC) + ((size_t)b * 2 + (t - (tl - 2))) * 1024 + c0;
#pragma unroll
            for (int k = 0; k < 16; ++k) dst[k] = p2[k];
        }
#pragma unroll
        for (int k = 0; k < 16; ++k) { p0[k] = p1[k]; p1[k] = p2[k]; }
    }
}

__device__ __forceinline__ void phase_tap(const Params& P, int which, const int tid, const int bid) {
    float* dst = P.out + OFF_YS;
    for (int idx = bid * 512 + tid; idx < 512 * 1024; idx += gridDim.x * 512) {
        const int k = idx >> 10, c = idx & 1023;
        int row, keyrow;
        if (k < 256) { const int b = k >> 5, q = k & 31; row = b * LSEQ + (LSEQ - 32) + q; keyrow = row; }
        else { const int b = (k - 256) >> 5, q = (k - 256) & 31; row = NP + b * 64 + 32 + q; keyrow = NP + b * 1088 + 1024 + 32 + q; }
        float v = 0.f;
        if (which == 0) v = bf2f(((const bf16_t*)(P.ws + OFF_H))[(size_t)row * 1024 + c]);
        else if (which == 1) v = c < 768 ? bf2f(((const bf16_t*)(P.ws + OFF_Q))[(size_t)row * 768 + c]) : 0.f;
        else if (which == 2) v = c < 512 ? bf2f(((const bf16_t*)(P.ws + OFF_KN))[(size_t)keyrow * 512 + c]) : bf2f(((const bf16_t*)(P.ws + OFF_VT))[(size_t)(c - 512) * MKP + keyrow]);
        else if (which >= 8 && which <= 12) {
            const int it64 = idx >> 13, e = idx & 8191;
            const int s_ = it64 >> 3, h_ = (it64 >> 1) & 3, c_ = 63 + (it64 & 1);
            const int item = s_ * 260 + h_ * 65 + c_;
            const unsigned char* dob = (const unsigned char*)P.out;
            if (which == 8) v = bf2f(((const bf16_t*)(dob + DO_QD))[(size_t)item * 8192 + e]);
            else if (which == 9) v = e < 4096 ? bf2f(((const bf16_t*)(P.ws + OFF_QK))[(size_t)item * 4096 + e]) : ((const float*)(P.ws + OFF_GL))[item];
            else if (which == 10) v = bf2f(((const bf16_t*)(dob + DO_WK))[(size_t)item * 8192 + e]);
            else if (which == 11) v = bf2f(((const bf16_t*)(dob + DO_UT))[(size_t)item * 8192 + e]);
            else v = bf2f(((const bf16_t*)(P.ws + OFF_KTT))[(size_t)item * 8192 + e]);
        }
        else if (which == 6) v = c < 512 ? bf2f(((const bf16_t*)(P.ws + OFF_H))[(size_t)row * 1024 + c]) : 0.f;
        else if (which == 7) v = c >= 512 ? bf2f(((const bf16_t*)(P.ws + OFF_H))[(size_t)row * 1024 + c]) : 0.f;
        else if (which == 3) v = ((const float*)(P.ws + OFF_X))[(size_t)row * 1024 + c];
        else if (which == 4) v = bf2f(((const bf16_t*)(P.ws + OFF_P))[(size_t)row * 1024 + c]);
        else if (which == 5) v = bf2f(((const bf16_t*)(P.ws + OFF_BG))[(size_t)row * 1024 + c]);
        dst[idx] = v;
    }
}

__device__ __forceinline__ void panel_barrier(unsigned* cnt, unsigned want, const int tid) {
    asm volatile("s_waitcnt vmcnt(0)" ::: "memory");
    __syncthreads();
    if (tid == 0) {
        __builtin_amdgcn_fence(__ATOMIC_RELEASE, "agent");
        asm volatile("s_waitcnt vmcnt(0)" ::: "memory");
        (void)__hip_atomic_fetch_add(cnt, 1u, __ATOMIC_RELAXED, __HIP_MEMORY_SCOPE_AGENT);
        unsigned sp = 0;
        while (__hip_atomic_load(cnt, __ATOMIC_RELAXED, __HIP_MEMORY_SCOPE_AGENT) < want) { __builtin_amdgcn_s_sleep(2); if (++sp > (1u << 22)) break; }
        __builtin_amdgcn_fence(__ATOMIC_ACQUIRE, "agent");
        asm volatile("s_waitcnt vmcnt(0)" ::: "memory");
    }
    __syncthreads();
}
constexpr int MAIN_ROWS = 32768, MAIN_WGS = 244;
constexpr size_t OFF_PCNT = OFF_RSS + 16384;
template <class EpiC>
__device__ __forceinline__ void consumer_gemm(const Params& P, LAS unsigned char* L, const bf16_t* A, const bf16_t* Bt, int N, int K, const EpiC& EC, int down_arg, int slot, int tid, int bid, bool is_cons = true, int prod = 0) {
    if (!is_cons || bid < MAIN_WGS) { run_gemm(L, A, Bt, is_cons ? MAIN_ROWS : MP, N, K, EC, tid, bid, is_cons ? MAIN_WGS : (int)gridDim.x); return; }
    const int j = bid - MAIN_WGS, panel = 128 + (j >> 2), q = j & 3;
#pragma unroll 1
    for (int pass = 0; pass < (prod == 2 ? 2 : 1); ++pass) {
        const bool fin = pass == 1, dn = fin || prod == 0;
        if (fin) panel_barrier((unsigned*)(P.ws + OFF_PCNT) + (5 * 3 + (panel - 128)) * 64, 4u, tid);
        EpiAddX ED; ED.X = (float*)(P.ws + OFF_X); ED.scale = dn ? 0.5f : 1.0f; ED.out = P.out; ED.final_ = fin ? 1 : 0; ED.xb = dn ? (bf16_t*)(P.ws + OFF_H) : (bf16_t*)P.out; ED.rss = (float*)(P.ws + OFF_SPARE);
        const bf16_t* pA = dn ? (const bf16_t*)(P.ws + OFF_GU) : (const bf16_t*)(P.ws + OFF_H);
        const bf16_t* pB = dn ? (const bf16_t*)(P.ws + OFF_WD + (size_t)(fin ? 3 : down_arg) * SZ_WD) : (prod == 1 ? (const bf16_t*)(P.ws + OFF_WOUT) : (const bf16_t*)(P.ws + OFF_WSCOUT));
        run_gemm_strip(L, pA, pB, 1024, dn ? 2816 : 1024, ED, tid, panel, q, 4);
        if (!fin) {
            panel_barrier((unsigned*)(P.ws + OFF_PCNT) + (slot * 3 + (panel - 128)) * 64, 4u, tid);
            run_gemm_strip(L, A, Bt, N, K, EC, tid, panel, q, 4);
        }
    }
}

#define XB_TMO      128
#define XB_XCNT(j)  (256  + 64 * (j))
#define XB_XSUB(j)  (1280 + 64 * (j))
#define XB_XGEN(j)  (2304 + 64 * (j))
#define XB_TOP      3328
#define XB_TOPGEN   3392
#define XCD_BAR_WORDS 3456
#define XB_SPIN_CAP (1u << 18)
__device__ __forceinline__ unsigned xb_ld(unsigned* p)              { return __hip_atomic_load(p, __ATOMIC_RELAXED, __HIP_MEMORY_SCOPE_AGENT); }
__device__ __forceinline__ unsigned xb_add(unsigned* p, unsigned v) { return __hip_atomic_fetch_add(p, v, __ATOMIC_RELAXED, __HIP_MEMORY_SCOPE_AGENT); }
__device__ __forceinline__ unsigned xb_xcc_id() { return (unsigned)__builtin_amdgcn_s_getreg((3 << 11) | 20) & 0xFu; }
#define XB_SPIN(cond, bar) do { unsigned _sp = 0; while (cond) { __builtin_amdgcn_s_sleep(1); \
    if ((++_sp & 255u) == 0u) { if (xb_ld(&(bar)[XB_TMO])) break; if (_sp > XB_SPIN_CAP) { atomicAdd(&(bar)[XB_TMO], 1u); break; } } } } while (0)
struct XcdBarrier { unsigned* bar; unsigned x; volatile LAS unsigned* st; };
__device__ __forceinline__ XcdBarrier xcd_barrier_post(unsigned* bar, volatile LAS unsigned* st) {
    XcdBarrier b; b.bar = bar; b.x = xb_xcc_id(); b.st = st;
    if (threadIdx.x == 0) (void)xb_add(&bar[XB_XCNT(b.x)], 1u);
    return b;
}
__device__ __forceinline__ void xcd_barrier_complete(unsigned* bar, unsigned x, unsigned& nloc, unsigned& nx) {
    const unsigned G = gridDim.x * gridDim.y * gridDim.z;
    unsigned sum, cnt, mine, sp = 0u;
    for (;;) {
        sum = 0u; cnt = 0u; mine = 0u;
#pragma unroll
        for (unsigned j = 0; j < 16; ++j) { const unsigned c = xb_ld(&bar[XB_XCNT(j)]); sum += c; cnt += (c > 0u) ? 1u : 0u; mine = (j == x) ? c : mine; }
        if (sum == G) break;
        __builtin_amdgcn_s_sleep(1);
        if ((++sp & 255u) == 0u) { if (xb_ld(&bar[XB_TMO])) break; if (sp > XB_SPIN_CAP) { atomicAdd(&bar[XB_TMO], 1u); break; } }
    }
    nloc = mine > 0u ? mine : 1u; nx = cnt > 0u ? cnt : 1u;
}
__device__ __forceinline__ void xcd_barrier(const XcdBarrier& b) {
    asm volatile("s_waitcnt vmcnt(0)" ::: "memory");
    __syncthreads();
    if (threadIdx.x == 0) {
        unsigned* bar = b.bar;
        __builtin_amdgcn_s_waitcnt(0);
        unsigned nloc = b.st[0], nx = b.st[1];
        if (nloc == 0u) { xcd_barrier_complete(bar, b.x, nloc, nx); b.st[0] = nloc; b.st[1] = nx; }
        const unsigned old = xb_add(&bar[XB_XSUB(b.x)], 1u);
        const unsigned gen = old / nloc;
        if (old + 1u == (gen + 1u) * nloc) {
            __builtin_amdgcn_fence(__ATOMIC_RELEASE, "agent");
            asm volatile("s_waitcnt vmcnt(0)" ::: "memory");
            const unsigned og = xb_add(&bar[XB_TOP], 1u);
            const unsigned tg = og / nx;
            if (og + 1u == (tg + 1u) * nx) xb_add(&bar[XB_TOPGEN], 1u);
            else XB_SPIN(xb_ld(&bar[XB_TOPGEN]) == tg, bar);
            __builtin_amdgcn_fence(__ATOMIC_ACQUIRE, "agent");
            xb_add(&bar[XB_XGEN(b.x)], 1u);
            asm volatile("s_waitcnt vmcnt(0)" ::: "memory");
        } else {
            XB_SPIN(xb_ld(&bar[XB_XGEN(b.x)]) == gen, bar);
            __builtin_amdgcn_fence(__ATOMIC_ACQUIRE, "agent");
            asm volatile("s_waitcnt vmcnt(0)" ::: "memory");
        }
    }
    __syncthreads();
}

#ifndef DUP_PHASE
#define DUP_PHASE -1
#endif
constexpr int N_PHASES = 18;
#ifndef ONLY_KIND
#define ONLY_KIND -1
#endif
#ifndef K8SUB
#define K8SUB 7
#endif
#define BLK_ID blockIdx.x
#define EN(k) (ONLY_KIND < 0 || ONLY_KIND == (k))
__global__ __launch_bounds__(512, 2) void mega(Params P0, int ph_lo, int ph_hi) {
    extern __shared__ __attribute__((aligned(16))) unsigned char lds_raw[];
    LAS unsigned char* L = (LAS unsigned char*)lds_raw;
    cg::grid_group grid = cg::this_grid();
    volatile LAS unsigned* xbst = (volatile LAS unsigned*)(L + 152576);
    if (threadIdx.x == 0) { xbst[0] = 0u; xbst[1] = 0u; }
    __syncthreads();
    const XcdBarrier xb = xcd_barrier_post((unsigned*)(P0.ws + OFF_RSS), xbst);
#ifndef EXTRA_SYNCS
#define EXTRA_SYNCS 0
#endif
    for (int es = 0; es < EXTRA_SYNCS; ++es) { asm volatile("s_waitcnt vmcnt(0)" ::: "memory"); grid.sync(); }
#pragma unroll 1
    for (int pc = ph_lo; pc < ph_hi; ++pc) {
#if DUP_PHASE >= 0
        const int ph = pc > DUP_PHASE ? pc - 1 : pc;
#else
        const int ph = pc;
#endif
        int kind, arg = 0;
        switch (ph) {
            case 0: kind = 0; break;
            case 1: kind = 1; arg = 0; break;
            case 2: kind = 2; arg = 0; break;
            case 3: kind = 4; break;
            case 4: kind = 5; break;
            case 5: kind = 7; break;
            case 6: kind = 8; break;
            case 7: kind = 9; break;
            case 8: kind = 10; break;
            case 9: kind = 1; arg = 1; break;
            case 10: kind = 2; arg = 1; break;
            case 11: kind = 1; arg = 2; break;
            case 12: kind = 2; arg = 2; break;
            case 13: kind = 11; break;
            case 14: kind = 12; break;
            case 15: kind = 13; break;
            case 16: kind = 1; arg = 3; break;
            default: kind = 2; arg = 3; break;
        }
        int tid = threadIdx.x, bid = __builtin_amdgcn_readfirstlane((int)BLK_ID);
        asm volatile("" : "+v"(tid), "+s"(bid));
        Params P = P0;
        asm volatile("" : "+s"(P.ws), "+s"(P.out));
        unsigned char* ws = P.ws;
        float* X = (float*)(ws + OFF_X);
        bf16_t* H = (bf16_t*)(ws + OFF_H);
        bf16_t* GU = (bf16_t*)(ws + OFF_GU);
        float* RSS = (float*)(ws + OFF_SPARE);
        bf16_t* HALT = (bf16_t*)P.out;
        if (ph >= 100) { phase_tap(P, ph - 100, tid, bid); continue; }
        if (EN(0) && kind == 0) phase_init(P, L, tid, bid);
        else if (EN(1) && kind == 1) { EpiGU E; E.O = GU; E.rss = RSS; E.rsb = (LAS float*)(L + 131072); consumer_gemm(P, L, (arg & 1) ? HALT : H, (const bf16_t*)(ws + OFF_WGU + (size_t)arg * SZ_WGU), 5632, 1024, E, 1, arg == 1 ? 3 : (arg == 2 ? 1 : 4), tid, bid, arg != 0, arg == 1 ? 1 : (arg == 2 ? 0 : 2));
            if (arg == 0 && bid >= 66) convert_group(P, L, tid, 5, bid - 66, (int)gridDim.x - 66); }
        else if (EN(2) && kind == 2) { EpiAddX E; E.X = X; E.scale = 0.5f; E.out = P.out; E.final_ = (arg == 3) ? 1 : 0; E.xb = H; E.rss = RSS; run_gemm(L, GU, (const bf16_t*)(ws + OFF_WD + (size_t)arg * SZ_WD), MAIN_ROWS, 1024, 2816, E, tid, bid); }
        else if (EN(3) && kind == 3) {
            const float* g = arg == 0 ? P.in[16] : (arg == 1 ? P.in[12] : (arg == 2 ? P.in[8] + 1024 : (arg == 3 ? P.in[16] + 1024 : P.in[12] + 1024)));
            phase_norm(P, g, tid, bid);
        }
        else if (EN(4) && kind == 4) { EpiBf16 E; E.O = GU; E.ldc = HINW; E.rss = RSS; E.rsb = (LAS float*)(L + 131072); consumer_gemm(P, L, H, (const bf16_t*)(ws + OFF_WIN), 2816, 1024, E, 0, 0, tid, bid); }
        else if (EN(5) && kind == 5) {
#ifndef GDN_SKIP
#define GDN_SKIP 0
#endif
#ifndef G1_SKIPM
#define G1_SKIPM 0
#endif
            const bool dup_run = DUP_PHASE >= 0 && pc == DUP_PHASE + 1;
            if (bid < 64) { if (!(dup_run && (GDN_SKIP & 1))) { int t2 = tid, b2 = bid; asm volatile("" : "+v"(t2), "+s"(b2)); phase_scan(P, L, t2, b2); } }
            else { if (!(dup_run && (GDN_SKIP & 2))) { int t2 = tid, b2 = bid; asm volatile("" : "+v"(t2), "+s"(b2)); phase_g1(P, L, t2, b2, dup_run ? G1_SKIPM : 0);
                    convert_group(P, L, t2, 1, b2 - 64, (int)gridDim.x - 64); convert_group(P, L, t2, 2, b2 - 64, (int)gridDim.x - 64); convert_group(P, L, t2, 3, b2 - 64, (int)gridDim.x - 64); } }
        }
        else if (EN(7) && kind == 7) phase_mlaprep(P, tid, bid);
        else if (EN(8) && kind == 8) {
            if (K8SUB & 1) { EpiQ E; E.Q = (bf16_t*)(ws + OFF_Q); E.qn = P.in[27]; E.qr = P.in[28]; E.rope = (const float2*)(ws + OFF_ROPE); E.scale = 0.10206207261596577f * 1.4426950408889634f;
              run_gemm(L, (const bf16_t*)(ws + OFF_CQ), (const bf16_t*)(ws + OFF_WUQ), MP, 768, 384, E, tid, bid); }
            if (K8SUB & 2) { EpiKN E; E.KN = (bf16_t*)(ws + OFF_KN); E.kn = P.in[29];
              run_gemm(L, (const bf16_t*)(ws + OFF_CKVA), (const bf16_t*)(ws + OFF_WUKVK), MKP, 512, 256, E, tid, bid); }
            if (K8SUB & 4) { EpiBf16 E; E.O = (bf16_t*)(ws + OFF_VT); E.ldc = MKP; E.rss = nullptr; E.rsb = (LAS float*)(L + 131072);
              run_gemm(L, (const bf16_t*)(ws + OFF_WUKVV), (const bf16_t*)(ws + OFF_CKVA), 512, MKP, 256, E, tid, bid); }
        }
        else if (EN(9) && kind == 9) phase_attn(P, L, tid, bid);
        else if (EN(10) && kind == 10) { EpiAddX E; E.X = X; E.scale = 1.0f; E.out = P.out; E.final_ = 0; E.xb = HALT; E.rss = RSS; run_gemm(L, H, (const bf16_t*)(ws + OFF_WOUT), MAIN_ROWS, 1024, 1024, E, tid, bid); }
        else if (EN(11) && kind == 11) { EpiSC E; E.Pb = (bf16_t*)(ws + OFF_P); E.BG = (bf16_t*)(ws + OFF_BG); E.rss = RSS; E.rsb = (LAS float*)(L + 131072); consumer_gemm(P, L, H, (const bf16_t*)(ws + OFF_WSCIN), 3072, 1024, E, 2, 2, tid, bid); }
        else if (EN(12) && kind == 12) phase_sconv(P, tid, bid);
        else if (EN(13)) { EpiAddX E; E.X = X; E.scale = 1.0f; E.out = P.out; E.final_ = 0; E.xb = HALT; E.rss = RSS; run_gemm(L, H, (const bf16_t*)(ws + OFF_WSCOUT), MAIN_ROWS, 1024, 1024, E, tid, bid); }
        if (pc + 1 < ph_hi) {
            if (ph_hi > 4096) { asm volatile("s_waitcnt vmcnt(0)" ::: "memory"); grid.sync(); }
            else xcd_barrier(xb);
        }
    }
}

extern "C" void kernel_launch(void* const* d_in, const int* in_sizes, int n_in, void* d_out, int out_size, void* d_ws, size_t ws_size, hipStream_t stream) {
    static int grid_blocks = 0;
    if (grid_blocks == 0) {
        if (n_in != 34 || ws_size < WS_NEED) { fprintf(stderr, "kernel_launch: unexpected n_in %d / ws_size %zu (need %zu)\n", n_in, ws_size, (size_t)WS_NEED); grid_blocks = -1; return; }
        int dev = 0, cus = 0, per_cu = 0;
        (void)hipGetDevice(&dev);
        (void)hipDeviceGetAttribute(&cus, hipDeviceAttributeMultiprocessorCount, dev);
        if (hipFuncSetAttribute((const void*)mega, hipFuncAttributeMaxDynamicSharedMemorySize, LDS_BYTES) != hipSuccess) { fprintf(stderr, "kernel_launch: hipFuncSetAttribute failed\n"); grid_blocks = -1; return; }
        if (hipOccupancyMaxActiveBlocksPerMultiprocessor(&per_cu, (const void*)mega, 512, LDS_BYTES) != hipSuccess || per_cu < 1) { fprintf(stderr, "kernel_launch: occupancy query gave %d\n", per_cu); per_cu = 1; }
        (void)hipGetLastError();
        grid_blocks = cus * per_cu;
    }
    if (grid_blocks < 0) return;
    (void)hipMemsetAsync((unsigned char*)d_ws + OFF_RSS, 0, 20480, stream);
    Params p{};
    for (int i = 0; i < 34; ++i) p.in[i] = (const float*)d_in[i];
    p.out = (float*)d_out; p.ws = (unsigned char*)d_ws;
#ifndef MULTI_LAUNCH
#define MULTI_LAUNCH 0
#endif
#if MULTI_LAUNCH
#ifndef STOP_AT
#define STOP_AT N_PHASES
#endif
    for (int ph = 0; ph < STOP_AT; ++ph) {
        int lo = ph, hi = ph + 1;
        void* args[] = {&p, &lo, &hi};
        hipError_t e = hipLaunchCooperativeKernel((const void*)mega, dim3(grid_blocks), dim3(512), args, LDS_BYTES, stream);
        if (e != hipSuccess) { fprintf(stderr, "launch %d failed: %s (grid %d)\n", ph, hipGetErrorString(e), grid_blocks); break; }
    }
#ifdef TAP
    { int lo = 100 + TAP, hi = 101 + TAP; void* args[] = {&p, &lo, &hi};
      (void)hipLaunchCooperativeKernel((const void*)mega, dim3(grid_blocks), dim3(512), args, LDS_BYTES, stream); }
#endif
#else
    int lo = 0, hi = N_PHASES + (DUP_PHASE >= 0 ? 1 : 0);
    void* args[] = {&p, &lo, &hi};
    hipError_t e = hipLaunchCooperativeKernel((const void*)mega, dim3(grid_blocks), dim3(512), args, LDS_BYTES, stream);
    if (e != hipSuccess) fprintf(stderr, "cooperative launch failed: %s (grid %d)\n", hipGetErrorString(e), grid_blocks);
#endif
}
```

```cpp
#include <hip/hip_runtime.h>
#include <hip/hip_cooperative_groups.h>
#include <cstdio>
namespace cg = cooperative_groups;

#define LAS __attribute__((address_space(3)))
typedef unsigned short bf16_t;
typedef short bf16x8 __attribute__((ext_vector_type(8)));
typedef short bf16x4 __attribute__((ext_vector_type(4)));
typedef float f32x4 __attribute__((ext_vector_type(4)));
typedef unsigned u32x4 __attribute__((ext_vector_type(4)));
typedef unsigned u32x2 __attribute__((ext_vector_type(2)));

constexpr int DM = 1024, LSEQ = 4112, NP = 8 * LSEQ  , NS = 512, MT = NP + NS  , MP = 33536  ;
constexpr int DFF = 2816, HINW = 2816;
constexpr int MK = NP + 8 * 1088  , MKP = 41728  ;
constexpr float EPS = 1e-6f;
constexpr int N_G1_ITEMS = 8 * 4 * 65 + 32;

constexpr size_t SZ_WGU = (size_t)5632 * 1024 * 2, SZ_WD = (size_t)1024 * 2816 * 2;
constexpr size_t OFF_WGU = 0;
constexpr size_t OFF_WD = OFF_WGU + 4 * SZ_WGU;
constexpr size_t OFF_WIN = OFF_WD + 4 * SZ_WD;
constexpr size_t OFF_WOUT = OFF_WIN + (size_t)2816 * 1024 * 2;
constexpr size_t OFF_WUQ = OFF_WOUT + (size_t)1024 * 1024 * 2;
constexpr size_t OFF_WUKVK = OFF_WUQ + (size_t)768 * 384 * 2;
constexpr size_t OFF_WUKVV = OFF_WUKVK + (size_t)512 * 256 * 2;
constexpr size_t OFF_WSCIN = OFF_WUKVV + (size_t)512 * 256 * 2;
constexpr size_t OFF_WSCOUT = OFF_WSCIN + (size_t)3072 * 1024 * 2;
constexpr size_t OFF_ROPE = OFF_WSCOUT + (size_t)1024 * 1024 * 2;
constexpr size_t OFF_RSS = OFF_ROPE + (size_t)LSEQ * 16 * 8;
constexpr size_t OFF_X = OFF_RSS + (size_t)6 * MP * 4;
constexpr size_t OFF_H = OFF_X + (size_t)MP * 1024 * 4;
constexpr size_t OFF_GU = OFF_H + (size_t)MP * 1024 * 2;
constexpr size_t OFF_SPARE = OFF_GU + (size_t)MP * 2816 * 2;
constexpr size_t OFF_KTT = OFF_SPARE;
constexpr size_t OFF_QK = OFF_KTT + (size_t)N_G1_ITEMS * 16384;
constexpr size_t OFF_GL = OFF_QK + (size_t)N_G1_ITEMS * 8192;
constexpr size_t OFF_FLG = OFF_GL + (size_t)N_G1_ITEMS * 4;
constexpr size_t END_GDN = OFF_FLG + (size_t)N_G1_ITEMS * 4;
constexpr size_t OFF_CQ = OFF_SPARE;
constexpr size_t OFF_CKVA = OFF_CQ + (size_t)MP * 384 * 2;
constexpr size_t OFF_KRA = OFF_CKVA + (size_t)MKP * 256 * 2;
constexpr size_t END_MLA = OFF_KRA + (size_t)MKP * 32 * 2;
constexpr size_t WS_NEED = (END_GDN > END_MLA ? END_GDN : END_MLA);
constexpr size_t OFF_Q = OFF_GU;
constexpr size_t OFF_KN = OFF_Q + (size_t)MP * 768 * 2;
constexpr size_t OFF_VT = OFF_KN + (size_t)MKP * 512 * 2;
constexpr size_t OFF_P = OFF_GU;
constexpr size_t OFF_BG = OFF_P + (size_t)MP * 1024 * 2;
static_assert(OFF_VT + (size_t)512 * MKP * 2 <= OFF_SPARE, "GU region overflow");
static_assert(WS_NEED <= (size_t)536870912, "workspace overflow");
constexpr size_t DO_WK = 0, DO_UT = (size_t)N_G1_ITEMS * 16384, DO_QD = 2 * (size_t)N_G1_ITEMS * 16384;
static_assert(3 * (size_t)N_G1_ITEMS * 16384 <= (size_t)33554432 * 4, "d_out scratch overflow");
constexpr size_t OFF_YP = 0, OFF_YS = 33554432, OFF_PCKV = 34078720, OFF_PKR = 42500096, OFF_PS = 43552768, OFF_PCONV = 44077056,
                 OFF_PSC = 44113920, OFF_SCKV = 44130304, OFF_SKR = 44261376, OFF_SS = 44277760, OFF_SCONV = 44802048, OFF_SSC = 44838912;

constexpr int LDS_BYTES = 152576 + 16;

struct Params {
    const float* in[34];
    float* out;
    unsigned char* ws;
};

__device__ const double kRopeInv[16] = {1.0, 0.5623413251903491, 0.31622776601683794, 0.1778279410038923, 0.1, 0.05623413251903491, 0.031622776601683794, 0.01778279410038923,
                                       0.01, 0.005623413251903491, 0.0031622776601683794, 0.001778279410038923, 0.001, 0.0005623413251903491, 0.00031622776601683794, 0.0001778279410038923};
__device__ __forceinline__ float bf2f(bf16_t h) { return __uint_as_float(((unsigned)h) << 16); }
__device__ __forceinline__ bf16_t f2bf(float f) { unsigned u = __float_as_uint(f); u += 0x7fffu + ((u >> 16) & 1u); return (bf16_t)(u >> 16); }
typedef float f32x2_t __attribute__((ext_vector_type(2)));
typedef __bf16 bf16x2_t __attribute__((ext_vector_type(2)));
__device__ __forceinline__ unsigned cvt_pk_bf16(float lo, float hi) { const f32x2_t v = {lo, hi}; return __builtin_bit_cast(unsigned, __builtin_convertvector(v, bf16x2_t)); }
__device__ __forceinline__ float wsum(float v) {
#pragma unroll
    for (int o = 32; o > 0; o >>= 1) v += __shfl_xor(v, o);
    return v;
}
__device__ __forceinline__ float silu_f(float x) { return x * __builtin_amdgcn_rcpf(1.0f + __expf(-x)); }
__device__ __forceinline__ float row_rs(const float* rssp, int row) {
    const f32x4 a = *(const f32x4*)(rssp + (size_t)row * 16), b = *(const f32x4*)(rssp + (size_t)row * 16 + 4);
    const f32x4 c = *(const f32x4*)(rssp + (size_t)row * 16 + 8), d = *(const f32x4*)(rssp + (size_t)row * 16 + 12);
    const f32x4 t = (a + b) + (c + d);
    return rsqrtf(((t[0] + t[1]) + (t[2] + t[3])) * (1.0f / 1024.0f) + EPS);
}
__device__ __forceinline__ void row_rs8(const float* rssp, int row0, int fq, float (&rsv)[2][4]) {
    f32x4 t[2][4];
#pragma unroll
    for (int ai = 0; ai < 2; ++ai)
#pragma unroll
        for (int m = 0; m < 4; ++m) t[ai][m] = *(const f32x4*)(rssp + (size_t)(row0 + ai * 128 + m * 16) * 16 + 4 * fq);
#pragma unroll
    for (int ai = 0; ai < 2; ++ai)
#pragma unroll
        for (int m = 0; m < 4; ++m) {
            float sv = (t[ai][m][0] + t[ai][m][1]) + (t[ai][m][2] + t[ai][m][3]);
            sv += __shfl_xor(sv, 16); sv += __shfl_xor(sv, 32);
            rsv[ai][m] = rsqrtf(sv * (1.0f / 1024.0f) + EPS);
        }
}
__device__ __forceinline__ void row_rs8_lds(LAS float* rsb, int ui, int wr, int fr, float (&rsv)[2][4]) {
#pragma unroll
    for (int ai = 0; ai < 2; ++ai)
#pragma unroll
        for (int m = 0; m < 4; ++m) rsv[ai][m] = rsb[ui * 256 + ai * 128 + wr * 64 + m * 16 + fr];
}
__device__ __forceinline__ f32x4 mfma16(bf16x8 a, bf16x8 b, f32x4 c) { return __builtin_amdgcn_mfma_f32_16x16x32_bf16(a, b, c, 0, 0, 0); }

namespace pg8 {
constexpr int BM = 256, BK = 64, HALF = 128, HTB = HALF * BK * 2, STAGE_BYTES = 8 * HTB, NXCD = 8, WGM = 8;
__device__ __forceinline__ int lds_byte(int r, int c) { const int st = (r >> 4) * 2 + (c >> 5), rr = r & 15, cc = c & 31, ob = rr * 64 + cc * 2; return st * 1024 + (ob ^ (((ob >> 9) & 1) << 5)); }
__device__ __forceinline__ void stage_rc(int b, int& R, int& C) { const int st = b / 1024, sb = b % 1024, swz = sb ^ (((sb >> 9) & 1) << 5); R = (st >> 1) * 16 + swz / 64; C = (st & 1) * 32 + (swz % 64) / 2; }
__device__ __forceinline__ int perm32(int rho) { const int n = rho >> 4, i = rho & 15; return 8 * (i >> 2) + 4 * n + (i & 3); }
struct Unit { int pm, pn; };
struct Gemm { const bf16_t* A; const bf16_t* Bt; int M, N, K; };
struct StaticOrder {
    int nM, nN, nwg, G, c, strip, pm0, pn0, pstep;
    __device__ void init(int M, int N, int G_, int c_) { nM = M / BM; nN = N / BM; nwg = nM * nN; G = G_; c = c_; strip = 0; pm0 = 0; pn0 = 0; pstep = 1; }
    __device__ void init_strip(int N, int pm0_, int pn0_, int pstep_) { nM = 1; nN = N / BM; nwg = 0; G = 1; c = 0; strip = 1; pm0 = pm0_; pn0 = pn0_; pstep = pstep_; }
    __device__ bool next(int i, Unit& u) const {
        if (strip) { const int pn = pn0 + i * pstep; if (pn >= nN) return false; u.pm = pm0; u.pn = pn; return true; }
        const long L = (long)i * G + c; if (L >= nwg) return false;
        int wgid = (int)L; { const int q = nwg / NXCD, r = nwg % NXCD, xcd = wgid % NXCD, off = wgid / NXCD; wgid = (xcd < r ? xcd * (q + 1) : r * (q + 1) + (xcd - r) * q) + off; }
        const int nig = WGM * nN, gid = wgid / nig, fm = gid * WGM, gsz = (nM - fm) < WGM ? (nM - fm) : WGM;
        u.pm = fm + ((wgid % nig) % gsz); u.pn = (wgid % nig) / gsz; return true;
    }
};
template <class Epi>
__device__ __forceinline__ void gemm_phase(LAS unsigned char* lds, const Gemm g, const StaticOrder& S, const Epi& E, const int tid) {
    const int wid = __builtin_amdgcn_readfirstlane(tid >> 6), lane = tid & 63, wr = wid >> 2, wc = wid & 3, fr = lane & 15, fq = lane >> 4;
    const int K = g.K, nt = K / BK;
    unsigned voffA[2], voffB[2];
#pragma unroll
    for (int i = 0; i < 2; ++i) { int R, C; stage_rc(tid * 16 + i * 8192, R, C); const int Rb = Epi::PERM ? ((R & ~31) + perm32(R & 31)) : R;
        voffA[i] = (unsigned)(R * K + C) * 2u; voffB[i] = (unsigned)(Rb * K + C) * 2u; }
    const size_t kstep = (size_t)(BK * 2);
    const size_t hstep = (size_t)HALF * K * 2;
    const size_t tstep = 2 * hstep;
    const unsigned ldsw = (unsigned)wid * 1024u;
    const int aoff = lds_byte(wr * 64 + fr, fq * 8), boff = lds_byte(wc * 32 + fr, fq * 8);
#define PG8_SA(b, h) (((b) * 2 + (h)) * HTB)
#define PG8_SB(b, h) ((4 + (b) * 2 + (h)) * HTB)
#define PG8_STAGE(bufoff, gbase, voff) do { _Pragma("unroll") for (int _i = 0; _i < 2; ++_i) \
        __builtin_amdgcn_global_load_lds((const unsigned*)((const char*)(gbase) + (voff)[_i]), (LAS unsigned*)(lds + (bufoff) + ldsw + _i * 8192), 16, 0, 0); } while (0)
#define PG8_LDA(dst, b, h) do { _Pragma("unroll") for (int m = 0; m < 4; ++m) _Pragma("unroll") for (int k = 0; k < 2; ++k) dst[m][k] = *(const LAS bf16x8*)(lds + PG8_SA(b, h) + aoff + m * 2048 + k * 1024); } while (0)
#define PG8_LDB(dst, b, h) do { _Pragma("unroll") for (int n = 0; n < 2; ++n) _Pragma("unroll") for (int k = 0; k < 2; ++k) dst[n][k] = *(const LAS bf16x8*)(lds + PG8_SB(b, h) + boff + n * 2048 + k * 1024); } while (0)
#define PG8_MMA(ai, bj, At, Bt) do { __builtin_amdgcn_s_setprio(1); _Pragma("unroll") for (int m = 0; m < 4; ++m) _Pragma("unroll") for (int n = 0; n < 2; ++n) _Pragma("unroll") for (int k = 0; k < 2; ++k) \
        acc[ai][bj][m][n] = __builtin_amdgcn_mfma_f32_16x16x32_bf16(Bt[n][k], At[m][k], acc[ai][bj][m][n], 0, 0, 0); __builtin_amdgcn_s_setprio(0); } while (0)
#define PG8_WAIT_V(n) asm volatile("s_waitcnt vmcnt(" #n ")" ::: "memory")
#define PG8_WAIT_L(n) asm volatile("s_waitcnt lgkmcnt(" #n ")" ::: "memory")
#define PG8_BAR __builtin_amdgcn_s_barrier()
#define PG8_SCHED __builtin_amdgcn_sched_barrier(0)
    Unit cur, nxt; int ui = 0;
    if (!S.next(0, cur)) return;
    f32x4 acc[2][2][4][2];
#pragma unroll
    for (int a = 0; a < 2; ++a)
#pragma unroll
        for (int b = 0; b < 2; ++b)
#pragma unroll
            for (int m = 0; m < 4; ++m)
#pragma unroll
                for (int n = 0; n < 2; ++n) acc[a][b][m][n] = (f32x4){0.f, 0.f, 0.f, 0.f};
    bf16x8 At[4][2], B0[2][2], B1[2][2];
    const char* cA = (const char*)g.A + (size_t)cur.pm * tstep; const char* cB = (const char*)g.Bt + (size_t)cur.pn * tstep;
    PG8_STAGE(PG8_SB(0, 0), cB, voffB); PG8_STAGE(PG8_SA(0, 0), cA, voffA); PG8_STAGE(PG8_SB(0, 1), cB + hstep, voffB); PG8_STAGE(PG8_SA(0, 1), cA + hstep, voffA);
    if (wr == 1) PG8_BAR;
    PG8_WAIT_V(4); PG8_BAR;
    PG8_STAGE(PG8_SB(1, 0), cB + kstep, voffB); PG8_STAGE(PG8_SA(1, 0), cA + kstep, voffA); PG8_STAGE(PG8_SB(1, 1), cB + hstep + kstep, voffB);
    PG8_WAIT_V(6); PG8_BAR;
    for (;;) {
        const bool has_next = S.next(ui + 1, nxt);
        const char* nA = has_next ? (const char*)g.A + (size_t)nxt.pm * tstep : cA; const char* nB = has_next ? (const char*)g.Bt + (size_t)nxt.pn * tstep : cB;
#pragma unroll 1
        for (int t = 0; t < nt; t += 2) {
            const bool last = (t == nt - 2);
            const char* a1 = cA + (size_t)(t + 1) * kstep;
            const char* a2 = last ? nA : cA + (size_t)(t + 2) * kstep; const char* b2 = last ? nB : cB + (size_t)(t + 2) * kstep;
            const char* a3 = a2 + kstep; const char* b3 = b2 + kstep;
            PG8_LDB(B0, 0, 0); PG8_SCHED; PG8_LDA(At, 0, 0); PG8_STAGE(PG8_SA(1, 1), a1 + hstep, voffA);
            PG8_WAIT_L(8); PG8_BAR; PG8_WAIT_L(0); PG8_MMA(0, 0, At, B0); PG8_BAR; PG8_SCHED;
            PG8_LDB(B1, 0, 1); PG8_STAGE(PG8_SB(0, 0), b2, voffB);
            PG8_BAR; PG8_WAIT_L(0); PG8_MMA(0, 1, At, B1); PG8_BAR;
            PG8_LDA(At, 0, 1); PG8_STAGE(PG8_SA(0, 0), a2, voffA);
            PG8_BAR; PG8_WAIT_L(0); PG8_MMA(1, 0, At, B0); PG8_BAR; PG8_SCHED;
            PG8_STAGE(PG8_SB(0, 1), b2 + hstep, voffB);
            PG8_WAIT_V(6); PG8_BAR; PG8_MMA(1, 1, At, B1); PG8_BAR;
            PG8_LDB(B0, 1, 0); PG8_SCHED; PG8_LDA(At, 1, 0); PG8_STAGE(PG8_SA(0, 1), a2 + hstep, voffA);
            PG8_WAIT_L(8); PG8_BAR; PG8_WAIT_L(0); PG8_MMA(0, 0, At, B0); PG8_BAR; PG8_SCHED;
            PG8_LDB(B1, 1, 1); PG8_STAGE(PG8_SB(1, 0), b3, voffB);
            PG8_BAR; PG8_WAIT_L(0); PG8_MMA(0, 1, At, B1); PG8_BAR;
            PG8_LDA(At, 1, 1); PG8_STAGE(PG8_SA(1, 0), a3, voffA);
            PG8_BAR; PG8_WAIT_L(0); PG8_MMA(1, 0, At, B0); PG8_BAR; PG8_SCHED;
            PG8_STAGE(PG8_SB(1, 1), b3 + hstep, voffB);
            PG8_WAIT_V(6); PG8_BAR; PG8_MMA(1, 1, At, B1); PG8_BAR;
        }
        E(acc, cur, wr, wc, fr, fq, ui);
        if (!has_next) break;
#pragma unroll
        for (int a = 0; a < 2; ++a)
#pragma unroll
            for (int b = 0; b < 2; ++b)
#pragma unroll
                for (int m = 0; m < 4; ++m)
#pragma unroll
                    for (int n = 0; n < 2; ++n) acc[a][b][m][n] = (f32x4){0.f, 0.f, 0.f, 0.f};
        cur = nxt; cA = nA; cB = nB; ++ui;
    }
    PG8_WAIT_V(0);
    if (wr == 0) PG8_BAR;
    PG8_BAR;
#undef PG8_SA
#undef PG8_SB
#undef PG8_STAGE
#undef PG8_LDA
#undef PG8_LDB
#undef PG8_MMA
#undef PG8_WAIT_V
#undef PG8_WAIT_L
#undef PG8_BAR
#undef PG8_SCHED
}
}
using pg8::Unit;
typedef f32x4 AccT[2][2][4][2];

struct EpiGU {
    static constexpr bool PERM = true, NEEDS_RS = true;
    bf16_t* O; const float* rss; LAS float* rsb;
    __device__ __forceinline__ void operator()(const AccT& acc, const Unit& u, int wr, int wc, int fr, int fq, int ui) const {
        const int row0 = u.pm * 256 + wr * 64 + fr, col0 = u.pn * 128 + wc * 32 + 8 * fq;
        float rsv[2][4]; row_rs8_lds(rsb, ui, wr, fr, rsv);
#pragma unroll
        for (int ai = 0; ai < 2; ++ai)
#pragma unroll
            for (int m = 0; m < 4; ++m) {
                asm volatile("" ::: "memory");
                const float rs = rsv[ai][m];
                const f32x4 g0 = acc[ai][0][m][0] * rs, g1 = acc[ai][0][m][1] * rs, u0 = acc[ai][1][m][0] * rs, u1 = acc[ai][1][m][1] * rs;
                float v[8];
#pragma unroll
                for (int j = 0; j < 4; ++j) { v[j] = silu_f(g0[j]) * u0[j]; v[4 + j] = silu_f(g1[j]) * u1[j]; }
                u32x4 w; w.x = cvt_pk_bf16(v[0], v[1]); w.y = cvt_pk_bf16(v[2], v[3]); w.z = cvt_pk_bf16(v[4], v[5]); w.w = cvt_pk_bf16(v[6], v[7]);
                *(u32x4*)(O + (size_t)(row0 + ai * 128 + m * 16) * DFF + col0) = w;
            }
    }
};
struct EpiBf16 {
    static constexpr bool PERM = true, NEEDS_RS = true;
    bf16_t* O; int ldc; const float* rss; LAS float* rsb;
    __device__ __forceinline__ void operator()(const AccT& acc, const Unit& u, int wr, int wc, int fr, int fq, int ui) const {
        const int row0 = u.pm * 256 + wr * 64 + fr, col0 = u.pn * 256 + wc * 32 + 8 * fq;
        float rsv[2][4];
        if (rss) row_rs8_lds(rsb, ui, wr, fr, rsv);
        else {
#pragma unroll
            for (int ai = 0; ai < 2; ++ai)
#pragma unroll
                for (int m = 0; m < 4; ++m) rsv[ai][m] = 1.0f;
        }
#pragma unroll
        for (int ai = 0; ai < 2; ++ai)
#pragma unroll
            for (int m = 0; m < 4; ++m) {
                asm volatile("" ::: "memory");
                bf16_t* rowp = O + (size_t)(row0 + ai * 128 + m * 16) * ldc + col0;
                const float rs = rsv[ai][m];
#pragma unroll
                for (int bj = 0; bj < 2; ++bj) {
                    const f32x4 v0 = acc[ai][bj][m][0] * rs, v1 = acc[ai][bj][m][1] * rs;
                    u32x4 w; w.x = cvt_pk_bf16(v0[0], v0[1]); w.y = cvt_pk_bf16(v0[2], v0[3]); w.z = cvt_pk_bf16(v1[0], v1[1]); w.w = cvt_pk_bf16(v1[2], v1[3]);
                    *(u32x4*)(rowp + bj * 128) = w;
                }
            }
    }
};
struct EpiAddX {
    static constexpr bool PERM = false, NEEDS_RS = false;
    float* X; float scale; float* out; int final_; bf16_t* xb; float* rss;
    __device__ __forceinline__ void operator()(const AccT& acc, const Unit& u, int wr, int wc, int fr, int fq, int ui) const {
        const int row0 = u.pm * 256 + wr * 64 + fr, col0 = u.pn * 256 + wc * 32 + 4 * fq;
#pragma unroll
        for (int ai = 0; ai < 2; ++ai)
#pragma unroll
            for (int m = 0; m < 4; ++m) {
                if (m == 0) asm volatile("" ::: "memory");
                const int row = row0 + ai * 128 + m * 16;
                if (row < MT) {
                    float* xp = X + (size_t)row * 1024 + col0;
                    float* dp = xp; bool wr_ok = true;
                    if (final_) {
                        if (row < NP) { const int b = row / LSEQ, pos = row - b * LSEQ; wr_ok = pos >= 16; dp = out + OFF_YP + ((size_t)(b * 4096 + pos - 16)) * 1024 + col0; }
                        else dp = out + OFF_YS + (size_t)(row - NP) * 1024 + col0;
                    }
                    if (wr_ok) {
                        float ss = 0.f;
#pragma unroll
                        for (int bj = 0; bj < 2; ++bj)
#pragma unroll
                            for (int n = 0; n < 2; ++n) {
                                const f32x4 x = *(const f32x4*)(xp + bj * 128 + n * 16);
                                const f32x4 y = x + scale * acc[ai][bj][m][n];
                                *(f32x4*)(dp + bj * 128 + n * 16) = y;
                                if (!final_) {
                                    ss += y[0] * y[0] + y[1] * y[1] + y[2] * y[2] + y[3] * y[3];
                                    u32x2 w; w.x = cvt_pk_bf16(y[0], y[1]); w.y = cvt_pk_bf16(y[2], y[3]);
                                    *(u32x2*)(xb + (size_t)row * 1024 + col0 + bj * 128 + n * 16) = w;
                                }
                            }
                        if (!final_) {
                            ss += __shfl_xor(ss, 16); ss += __shfl_xor(ss, 32);
                            if (fq == 0) rss[(size_t)row * 16 + u.pn * 4 + wc] = ss;
                        }
                    }
                }
            }
    }
};
struct EpiQ {
    static constexpr bool PERM = false, NEEDS_RS = false;
    bf16_t* Q; const float* qn; const float* qr; const float2* rope; float scale;
    __device__ __forceinline__ void operator()(const AccT& acc, const Unit& u, int wr, int wc, int fr, int fq, int ui) const {
        const int row0 = u.pm * 256 + wr * 64 + fr;
        if (u.pn < 2) {
            const int head = 4 * u.pn + wc;
            f32x4 gq[2][2];
#pragma unroll
            for (int bj = 0; bj < 2; ++bj)
#pragma unroll
                for (int n = 0; n < 2; ++n) gq[bj][n] = *(const f32x4*)(qn + 32 * bj + 16 * n + 4 * fq);
#pragma unroll
            for (int ai = 0; ai < 2; ++ai)
#pragma unroll
                for (int m = 0; m < 4; ++m) {
                    asm volatile("" ::: "memory");
                    const int row = row0 + ai * 128 + m * 16;
                    float ss = 0.f;
#pragma unroll
                    for (int bj = 0; bj < 2; ++bj)
#pragma unroll
                        for (int n = 0; n < 2; ++n) { const f32x4 x = acc[ai][bj][m][n]; ss += x[0] * x[0] + x[1] * x[1] + x[2] * x[2] + x[3] * x[3]; }
                    ss += __shfl_xor(ss, 16); ss += __shfl_xor(ss, 32);
                    const float r = rsqrtf(ss * (1.0f / 64.0f) + EPS) * scale;
#pragma unroll
                    for (int bj = 0; bj < 2; ++bj)
#pragma unroll
                        for (int n = 0; n < 2; ++n) {
                            const f32x4 x = acc[ai][bj][m][n], g = gq[bj][n];
                            u32x2 w; w.x = cvt_pk_bf16(x[0] * r * g[0], x[1] * r * g[1]); w.y = cvt_pk_bf16(x[2] * r * g[2], x[3] * r * g[3]);
                            *(u32x2*)(Q + (size_t)row * 768 + head * 64 + 32 * bj + 16 * n + 4 * fq) = w;
                        }
                }
        } else {
            const f32x4 g1 = *(const f32x4*)(qr + 4 * fq), g2 = *(const f32x4*)(qr + 16 + 4 * fq);
#pragma unroll
            for (int ai = 0; ai < 2; ++ai)
#pragma unroll
                for (int m = 0; m < 4; ++m) {
                    asm volatile("" ::: "memory");
                    const int row = row0 + ai * 128 + m * 16;
                    int pos = 0;
                    if (row < NP) pos = row % LSEQ; else if (row < MT) pos = 1024 + ((row - NP) & 63);
                    const float2* rp = rope + pos * 16 + 4 * fq;
                    float2 cs[4];
#pragma unroll
                    for (int j = 0; j < 4; ++j) cs[j] = rp[j];
#pragma unroll
                    for (int bj = 0; bj < 2; ++bj) {
                        const int head = 4 * bj + wc;
                        const f32x4 x1 = acc[ai][bj][m][0], x2 = acc[ai][bj][m][1];
                        float ss = x1[0] * x1[0] + x1[1] * x1[1] + x1[2] * x1[2] + x1[3] * x1[3] + x2[0] * x2[0] + x2[1] * x2[1] + x2[2] * x2[2] + x2[3] * x2[3];
                        ss += __shfl_xor(ss, 16); ss += __shfl_xor(ss, 32);
                        const float r = rsqrtf(ss * (1.0f / 32.0f) + EPS);
                        float o1[4], o2[4];
#pragma unroll
                        for (int j = 0; j < 4; ++j) {
                            const float y1 = x1[j] * r * g1[j], y2 = x2[j] * r * g2[j];
                            o1[j] = (y1 * cs[j].x - y2 * cs[j].y) * scale; o2[j] = (y2 * cs[j].x + y1 * cs[j].y) * scale;
                        }
                        u32x2 w1, w2; w1.x = cvt_pk_bf16(o1[0], o1[1]); w1.y = cvt_pk_bf16(o1[2], o1[3]); w2.x = cvt_pk_bf16(o2[0], o2[1]); w2.y = cvt_pk_bf16(o2[2], o2[3]);
                        bf16_t* qp = Q + (size_t)row * 768 + 512 + head * 32 + 4 * fq;
                        *(u32x2*)qp = w1; *(u32x2*)(qp + 16) = w2;
                    }
                }
        }
    }
};
struct EpiKN {
    static constexpr bool PERM = false, NEEDS_RS = false;
    bf16_t* KN; const float* kn;
    __device__ __forceinline__ void operator()(const AccT& acc, const Unit& u, int wr, int wc, int fr, int fq, int ui) const {
        const int row0 = u.pm * 256 + wr * 64 + fr, head = 4 * u.pn + wc;
        f32x4 gk[2][2];
#pragma unroll
        for (int bj = 0; bj < 2; ++bj)
#pragma unroll
            for (int n = 0; n < 2; ++n) gk[bj][n] = *(const f32x4*)(kn + 32 * bj + 16 * n + 4 * fq);
#pragma unroll
        for (int ai = 0; ai < 2; ++ai)
#pragma unroll
            for (int m = 0; m < 4; ++m) {
                asm volatile("" ::: "memory");
                const int row = row0 + ai * 128 + m * 16;
                float ss = 0.f;
#pragma unroll
                for (int bj = 0; bj < 2; ++bj)
#pragma unroll
                    for (int n = 0; n < 2; ++n) { const f32x4 x = acc[ai][bj][m][n]; ss += x[0] * x[0] + x[1] * x[1] + x[2] * x[2] + x[3] * x[3]; }
                ss += __shfl_xor(ss, 16); ss += __shfl_xor(ss, 32);
                const float r = rsqrtf(ss * (1.0f / 64.0f) + EPS);
#pragma unroll
                for (int bj = 0; bj < 2; ++bj)
#pragma unroll
                    for (int n = 0; n < 2; ++n) {
                        const f32x4 x = acc[ai][bj][m][n], g = gk[bj][n];
                        u32x2 w; w.x = cvt_pk_bf16(x[0] * r * g[0], x[1] * r * g[1]); w.y = cvt_pk_bf16(x[2] * r * g[2], x[3] * r * g[3]);
                        *(u32x2*)(KN + (size_t)row * 512 + head * 64 + 32 * bj + 16 * n + 4 * fq) = w;
                    }
            }
    }
};
struct EpiSC {
    static constexpr bool PERM = true, NEEDS_RS = true;
    bf16_t* Pb; bf16_t* BG; const float* rss; LAS float* rsb;
    __device__ __forceinline__ void operator()(const AccT& acc, const Unit& u, int wr, int wc, int fr, int fq, int ui) const {
        const int row0 = u.pm * 256 + wr * 64 + fr;
        float rsv[2][4]; row_rs8_lds(rsb, ui, wr, fr, rsv);
        if (u.pn < 8) {
            const int col0 = u.pn * 128 + wc * 32 + 8 * fq;
#pragma unroll
            for (int ai = 0; ai < 2; ++ai)
#pragma unroll
                for (int m = 0; m < 4; ++m) {
                    asm volatile("" ::: "memory");
                    const float rs = rsv[ai][m], rs2 = rs * rs;
                    const f32x4 c0 = acc[ai][0][m][0] * rs2, c1 = acc[ai][0][m][1] * rs2, x0 = acc[ai][1][m][0], x1 = acc[ai][1][m][1];
                    u32x4 w; w.x = cvt_pk_bf16(c0[0] * x0[0], c0[1] * x0[1]); w.y = cvt_pk_bf16(c0[2] * x0[2], c0[3] * x0[3]);
                    w.z = cvt_pk_bf16(c1[0] * x1[0], c1[1] * x1[1]); w.w = cvt_pk_bf16(c1[2] * x1[2], c1[3] * x1[3]);
                    *(u32x4*)(Pb + (size_t)(row0 + ai * 128 + m * 16) * 1024 + col0) = w;
                }
        } else {
            const int col0 = (u.pn - 8) * 256 + wc * 32 + 8 * fq;
#pragma unroll
            for (int ai = 0; ai < 2; ++ai)
#pragma unroll
                for (int m = 0; m < 4; ++m) {
                    asm volatile("" ::: "memory");
                    bf16_t* rowp = BG + (size_t)(row0 + ai * 128 + m * 16) * 1024 + col0;
                    const float rs = rsv[ai][m];
#pragma unroll
                    for (int bj = 0; bj < 2; ++bj) {
                        const f32x4 v0 = acc[ai][bj][m][0] * rs, v1 = acc[ai][bj][m][1] * rs;
                        u32x4 w; w.x = cvt_pk_bf16(v0[0], v0[1]); w.y = cvt_pk_bf16(v0[2], v0[3]); w.z = cvt_pk_bf16(v1[0], v1[1]); w.w = cvt_pk_bf16(v1[2], v1[3]);
                        *(u32x4*)(rowp + bj * 128) = w;
                    }
                }
        }
    }
};

template <class Epi>
__device__ __forceinline__ void run_gemm_order(LAS unsigned char* lds, const bf16_t* A, const bf16_t* Bt, int M, int N, int K, const Epi& E, int tid, const pg8::StaticOrder& S);
template <class Epi>
__device__ __forceinline__ void run_gemm(LAS unsigned char* lds, const bf16_t* A, const bf16_t* Bt, int M, int N, int K, const Epi& E, int tid, int bid, int Gv = 0) {
    asm volatile("" : "+v"(tid), "+s"(bid));
    pg8::StaticOrder S; S.init(M, N, Gv ? Gv : (int)gridDim.x, bid);
    run_gemm_order<Epi>(lds, A, Bt, M, N, K, E, tid, S);
}
template <class Epi>
__device__ __forceinline__ void run_gemm_strip(LAS unsigned char* lds, const bf16_t* A, const bf16_t* Bt, int N, int K, const Epi& E, int tid, int pm0, int pn0, int pstep) {
    asm volatile("" : "+v"(tid), "+s"(pm0));
    pg8::StaticOrder S; S.init_strip(N, pm0, pn0, pstep);
    run_gemm_order<Epi>(lds, A, Bt, 0, N, K, E, tid, S);
}
template <class Epi>
__device__ __forceinline__ void run_gemm_order(LAS unsigned char* lds, const bf16_t* A, const bf16_t* Bt, int M, int N, int K, const Epi& E, int tid, const pg8::StaticOrder& S) {
    pg8::Gemm g; g.A = A; g.Bt = Bt; g.M = M; g.N = N; g.K = K;
    if constexpr (Epi::NEEDS_RS) {
        if (E.rss) {
            LAS float* rsb = (LAS float*)(lds + 131072);
            const int r = tid >> 1, hf = tid & 1;
#pragma unroll 4
            for (int i = 0; i < 16; ++i) {
                pg8::Unit u; const bool ok = S.next(i, u); const int pm = ok ? u.pm : 0;
                const float* p = E.rss + ((size_t)(pm * 256 + r)) * 16 + 8 * hf;
                const f32x4 a = *(const f32x4*)p, b = *(const f32x4*)(p + 4);
                float sv = ((a[0] + a[1]) + (a[2] + a[3])) + ((b[0] + b[1]) + (b[2] + b[3]));
                sv += __shfl_xor(sv, 1);
                if (ok && hf == 0) rsb[i * 256 + r] = rsqrtf(sv * (1.0f / 1024.0f) + EPS);
            }
            __syncthreads();
        }
    }
    pg8::gemm_phase<Epi>(lds, g, S, E, tid);
    __syncthreads();
}

__device__ __forceinline__ int map_col(int type, int n, int ncols) {
    if (type == 0) return n < ncols ? n : -1;
    if (type == 1) { return 128 * (n >> 8) + (n & 127); }
    if (type == 2) {
        if (n < 512) { const int pn = n >> 8, rr = n & 255, bj = rr >> 7, wc = (rr >> 5) & 3, x = rr & 31; return (4 * pn + wc) * 96 + 32 * bj + x; }
        const int rr = n - 512, bj = rr >> 7, wc = (rr >> 5) & 3, x = rr & 31; return (4 * bj + wc) * 96 + 64 + x;
    }
    if (type == 3) { const int pn = n >> 8, rr = n & 255, bj = rr >> 7, wc = (rr >> 5) & 3, x = rr & 31; return (4 * pn + wc) * 128 + 32 * bj + x; }
    if (type == 4) return (n >> 6) * 128 + 64 + (n & 63);
    { const int pn = n >> 8, r = n & 255; if (pn < 8) return (r < 128 ? 1024 : 2048) + 128 * pn + (r & 127); return n - 2048; }
}

__device__ __forceinline__ void norm_row_store(const float4 (&v)[4], float ss, const float* g, bf16_t* h, int lane) {
    const float r = rsqrtf(ss * (1.0f / 1024.0f) + EPS);
#pragma unroll
    for (int i = 0; i < 4; ++i) {
        const float4 gg = ((const float4*)g)[lane + 64 * i];
        u32x2 w; w.x = cvt_pk_bf16(v[i].x * r * gg.x, v[i].y * r * gg.y); w.y = cvt_pk_bf16(v[i].z * r * gg.z, v[i].w * r * gg.w);
        *(u32x2*)(h + 4 * (lane + 64 * i)) = w;
    }
}

__device__ __forceinline__ void convert_tile(const Params& P, LAS unsigned char* L, const int tid, const int tile) {
    LAS float* T = (LAS float*)L;
    unsigned char* ws = P.ws;
    {
        const float* s0; const float* s1; bf16_t* dst; int ld, K, type, ncols, lt; const float* gk = nullptr;
        if (tile < 5632) { const int j = tile / 1408; lt = tile - j * 1408; const int l = j >> 1, f = j & 1;
            s0 = (f ? P.in[13] : P.in[9]) + (size_t)l * 1024 * 2816; s1 = (f ? P.in[14] : P.in[10]) + (size_t)l * 1024 * 2816;
            dst = (bf16_t*)(ws + OFF_WGU + (size_t)j * SZ_WGU); ld = 2816; K = 1024; type = 1; ncols = 2816; gk = (f ? P.in[12] : P.in[8]) + l * 1024; }
        else if (tile < 8448) { const int j = (tile - 5632) / 704; lt = (tile - 5632) - j * 704; const int l = j >> 1, f = j & 1;
            s0 = (f ? P.in[15] : P.in[11]) + (size_t)l * 2816 * 1024; s1 = s0;
            dst = (bf16_t*)(ws + OFF_WD + (size_t)j * SZ_WD); ld = 1024; K = 2816; type = 0; ncols = 1024; }
        else if (tile < 9152) { lt = tile - 8448; s0 = s1 = P.in[17]; dst = (bf16_t*)(ws + OFF_WIN); ld = 2728; K = 1024; type = 0; ncols = 2728; gk = P.in[16]; }
        else if (tile < 9408) { lt = tile - 9152; s0 = s1 = P.in[18]; dst = (bf16_t*)(ws + OFF_WOUT); ld = 1024; K = 1024; type = 0; ncols = 1024; }
        else if (tile < 9480) { lt = tile - 9408; s0 = s1 = P.in[24]; dst = (bf16_t*)(ws + OFF_WUQ); ld = 768; K = 384; type = 2; ncols = 768; }
        else if (tile < 9512) { lt = tile - 9480; s0 = s1 = P.in[26]; dst = (bf16_t*)(ws + OFF_WUKVK); ld = 1024; K = 256; type = 3; ncols = 1024; }
        else if (tile < 9544) { lt = tile - 9512; s0 = s1 = P.in[26]; dst = (bf16_t*)(ws + OFF_WUKVV); ld = 1024; K = 256; type = 4; ncols = 1024; }
        else if (tile < 10312) { lt = tile - 9544; s0 = s1 = P.in[31]; dst = (bf16_t*)(ws + OFF_WSCIN); ld = 3072; K = 1024; type = 5; ncols = 3072; gk = P.in[16] + 1024; }
        else { lt = tile - 10312; s0 = s1 = P.in[33]; dst = (bf16_t*)(ws + OFF_WSCOUT); ld = 1024; K = 1024; type = 0; ncols = 1024; }
        const int nkt = K >> 6, ntile = lt / nkt, ktile = lt - ntile * nkt, n0 = ntile * 64, k0 = ktile * 64;
        {
#pragma unroll
            for (int p = 0; p < 2; ++p) {
                const int id = tid + 512 * p, kk = id >> 4, n4 = (id & 15) * 4, n = n0 + n4;
                const int col = map_col(type, n, ncols);
                const float* src = (type == 1 && (n & 255) >= 128) ? s1 : s0;
                f32x4 v = (f32x4){0.f, 0.f, 0.f, 0.f};
                if (col >= 0) v = *(const f32x4*)(src + (size_t)(k0 + kk) * ld + col);
                if (gk) v = v * gk[k0 + kk];
                *(LAS f32x4*)(T + kk * 68 + n4) = v;
            }
        }
        __syncthreads();
        {
            const int nn = tid & 63, k8 = (tid >> 6) * 8;
            float v[8];
#pragma unroll
            for (int k = 0; k < 8; ++k) v[k] = T[(k8 + k) * 68 + nn];
            u32x4 wv; wv.x = cvt_pk_bf16(v[0], v[1]); wv.y = cvt_pk_bf16(v[2], v[3]); wv.z = cvt_pk_bf16(v[4], v[5]); wv.w = cvt_pk_bf16(v[6], v[7]);
            *(u32x4*)(dst + (size_t)(n0 + nn) * K + k0 + k8) = wv;
        }
        __syncthreads();
    }
}
__device__ __forceinline__ int group_tile(int grp, int k) {
    if (grp == 0) return k < 1408 ? k : (k < 2112 ? 5632 + (k - 1408) : 8448 + (k - 2112));
    if (grp == 1) return k < 1408 ? 1408 + k : (k < 2112 ? 6336 + (k - 1408) : (k < 3520 ? 2816 + (k - 2112) : 7040 + (k - 3520)));
    if (grp == 2) return k < 1408 ? 4224 + k : 7744 + (k - 1408);
    return 9544 + k;
}
__device__ __forceinline__ void convert_group(const Params& P, LAS unsigned char* L, const int tid, int grp, int start, int stride) {
    const int cnt = grp == 0 ? 3208 : (grp == 1 ? 4224 : (grp == 2 ? 2112 : 1024));
    for (int k = start; k < cnt; k += stride) convert_tile(P, L, tid, group_tile(grp, k));
}

__device__ __forceinline__ void phase_init(const Params& P, LAS unsigned char* L, const int tid, const int bid) {
    unsigned char* ws = P.ws;
    convert_group(P, L, tid, 0, bid, gridDim.x);
    {
        for (int idx = bid * 512 + tid; idx < N_G1_ITEMS; idx += gridDim.x * 512) ((unsigned*)(ws + OFF_FLG))[idx] = 0u;
        float2* rope = (float2*)(ws + OFF_ROPE);
        for (int idx = bid * 512 + tid; idx < LSEQ * 16; idx += gridDim.x * 512) {
            const int pos = idx >> 4, i = idx & 15;
            const double inv = kRopeInv[i];
            const double a = (double)pos * inv;
            const double kq = __builtin_rint(a * 0.15915494309189535);
            const double r = a - kq * 6.283185307179586476925;
            const double r2 = r * r;
            double s = 1.0 - r2 / 342.0; s = 1.0 - r2 / 272.0 * s; s = 1.0 - r2 / 210.0 * s; s = 1.0 - r2 / 156.0 * s; s = 1.0 - r2 / 110.0 * s;
            s = 1.0 - r2 / 72.0 * s; s = 1.0 - r2 / 42.0 * s; s = 1.0 - r2 / 20.0 * s; s = 1.0 - r2 / 6.0 * s; s = r * s;
            double c = 1.0 - r2 / 380.0; c = 1.0 - r2 / 306.0 * c; c = 1.0 - r2 / 240.0 * c; c = 1.0 - r2 / 182.0 * c; c = 1.0 - r2 / 132.0 * c;
            c = 1.0 - r2 / 90.0 * c; c = 1.0 - r2 / 56.0 * c; c = 1.0 - r2 / 30.0 * c; c = 1.0 - r2 / 12.0 * c; c = 1.0 - r2 / 2.0 * c;
            rope[idx] = make_float2((float)c, (float)s);
        }
    }
    {
        float* X = (float*)(ws + OFF_X); bf16_t* H = (bf16_t*)(ws + OFF_H); float* RSS = (float*)(ws + OFF_SPARE);
        const int wv = bid * 8 + (tid >> 6), nw = gridDim.x * 8, lane = tid & 63;
        float4 nv4[4];
        {
            const int r = wv;
            if (r < MT) {
                const float* src;
                if (r < NP) { const int b = r / LSEQ, pos = r - b * LSEQ; src = pos < 16 ? P.in[7] + (size_t)pos * 1024 : P.in[0] + ((size_t)b * 4096 + (pos - 16)) * 1024; }
                else src = P.in[1] + (size_t)(r - NP) * 1024;
#pragma unroll
                for (int i = 0; i < 4; ++i) nv4[i] = ((const float4*)src)[lane + 64 * i];
            } else {
#pragma unroll
                for (int i = 0; i < 4; ++i) nv4[i] = make_float4(0.f, 0.f, 0.f, 0.f);
            }
        }
        for (int r = wv; r < MP; r += nw) {
            bf16_t* h = H + (size_t)r * 1024;
            float4 v[4];
#pragma unroll
            for (int i = 0; i < 4; ++i) v[i] = nv4[i];
            {
                const int r2 = r + nw;
                if (r2 < MT) {
                    const float* src;
                    if (r2 < NP) { const int b = r2 / LSEQ, pos = r2 - b * LSEQ; src = pos < 16 ? P.in[7] + (size_t)pos * 1024 : P.in[0] + ((size_t)b * 4096 + (pos - 16)) * 1024; }
                    else src = P.in[1] + (size_t)(r2 - NP) * 1024;
#pragma unroll
                    for (int i = 0; i < 4; ++i) nv4[i] = ((const float4*)src)[lane + 64 * i];
                }
            }
            if (r >= MT) {
#pragma unroll
                for (int i = 0; i < 4; ++i) *(u32x2*)(h + 4 * (lane + 64 * i)) = (u32x2){0u, 0u};
                if (lane < 16) RSS[(size_t)r * 16 + lane] = 0.f;
                continue;
            }
            float ss = 0.f;
#pragma unroll
            for (int i = 0; i < 4; ++i) ss += v[i].x * v[i].x + v[i].y * v[i].y + v[i].z * v[i].z + v[i].w * v[i].w;
#pragma unroll
            for (int i = 0; i < 4; ++i) ((float4*)(X + (size_t)r * 1024))[lane + 64 * i] = v[i];
            ss = wsum(ss);
            if (lane < 16) RSS[(size_t)r * 16 + lane] = lane == 0 ? ss : 0.f;
#pragma unroll
            for (int i = 0; i < 4; ++i) { u32x2 w; w.x = cvt_pk_bf16(v[i].x, v[i].y); w.y = cvt_pk_bf16(v[i].z, v[i].w); *(u32x2*)(h + 4 * (lane + 64 * i)) = w; }
        }
    }
}

__device__ __forceinline__ void phase_norm(const Params& P, const float* g, const int tid, const int bid) {
    const float* X = (const float*)(P.ws + OFF_X); bf16_t* H = (bf16_t*)(P.ws + OFF_H);
    const int wv = bid * 8 + (tid >> 6), nw = gridDim.x * 8, lane = tid & 63;
    for (int r = wv; r < MP; r += nw) {
        bf16_t* h = H + (size_t)r * 1024;
        if (r >= MT) {
#pragma unroll
            for (int i = 0; i < 4; ++i) *(u32x2*)(h + 4 * (lane + 64 * i)) = (u32x2){0u, 0u};
            continue;
        }
        float4 v[4]; float ss = 0.f;
#pragma unroll
        for (int i = 0; i < 4; ++i) { v[i] = ((const float4*)(X + (size_t)r * 1024))[lane + 64 * i]; ss += v[i].x * v[i].x + v[i].y * v[i].y + v[i].z * v[i].z + v[i].w * v[i].w; }
        ss = wsum(ss);
        norm_row_store(v, ss, g, h, lane);
    }
}

__device__ __forceinline__ void phase_g1(const Params& P, LAS unsigned char* L, const int tid, const int bid, const int skipm = 0) {
    const int w = tid >> 6, lane = tid & 63, fr = lane & 15, fq = lane >> 4;
    LAS float* XT = (LAS float*)L;
    LAS bf16_t* RAW = (LAS bf16_t*)(L + 98304);
    LAS bf16_t* QB = (LAS bf16_t*)(L + 98304);
    LAS bf16_t* KB = (LAS bf16_t*)(L + 115712);
    LAS float* SG = (LAS float*)(L + 151040);
    LAS float* SEG = SG + 64; LAS float* SBETA = SG + 128; LAS float* SKDEC = SG + 192;
    const bf16_t* HIN = (const bf16_t*)(P.ws + OFF_GU);
    const float* convw = P.in[19];
    unsigned char* dob = (unsigned char*)P.out;
    unsigned* FLG = (unsigned*)(P.ws + OFF_FLG);
    for (int qi = bid - 64; qi < N_G1_ITEMS; qi += gridDim.x - 64) {
        int item;
        if (qi < 32) item = 2080 + qi;
        else { const int q2 = qi - 32, cc_ = q2 >> 5, sh_ = q2 & 31; item = (sh_ >> 2) * 260 + (sh_ & 3) * 65 + cc_; }
        int s, h, c, rb, nv; bool sample;
        if (item < 2080) { s = item / 260; const int r2 = item - s * 260; h = r2 / 65; c = r2 - h * 65; rb = s * LSEQ + 64 * c; nv = LSEQ - 64 * c; if (nv > 64) nv = 64; sample = false; }
        else { const int j = item - 2080; s = 8 + (j >> 2); h = j & 3; c = 0; rb = NP + (s - 8) * 64; nv = 64; sample = true; }
        bf16_t* WKo = (bf16_t*)(dob + DO_WK) + (size_t)item * 8192;
        bf16_t* UTo = (bf16_t*)(dob + DO_UT) + (size_t)item * 8192;
        bf16_t* QDo = (bf16_t*)(dob + DO_QD) + (size_t)item * 8192;
        bf16_t* KTTo = (bf16_t*)(P.ws + OFF_KTT) + (size_t)item * 8192;
        bf16_t* QKo = (bf16_t*)(P.ws + OFF_QK) + (size_t)item * 4096;
        float* GLo = (float*)(P.ws + OFF_GL) + item;
        {
            u32x4 rv[7];
#pragma unroll
            for (int it = 0; it < 7; ++it) {
                const int id = tid + 512 * it;
                u32x4 v = (u32x4){0u, 0u, 0u, 0u};
                if (id < 3216) {
                    const int row = id / 48, ch = id - row * 48, part = ch >> 4, c8 = (ch & 15) * 8, ri = row - 3;
                    const int col = part * 512 + h * 128 + c8;
                    if (ri >= 0) { if (ri < nv) v = *(const u32x4*)(HIN + (size_t)(rb + ri) * HINW + col); }
                    else if (c > 0) v = *(const u32x4*)(HIN + (size_t)(rb + ri) * HINW + col);
                    else if (sample) {
                        const float* sp = P.in[5] + ((size_t)(s - 8) * 3 + (3 + ri)) * 1536 + col;
                        const f32x4 a = *(const f32x4*)sp, b2 = *(const f32x4*)(sp + 4);
                        v.x = cvt_pk_bf16(a[0], a[1]); v.y = cvt_pk_bf16(a[2], a[3]); v.z = cvt_pk_bf16(b2[0], b2[1]); v.w = cvt_pk_bf16(b2[2], b2[3]);
                    }
                }
                rv[it] = v;
            }
#pragma unroll
            for (int it = 0; it < 7; ++it) {
                const int id = tid + 512 * it;
                if (id < 3216) { const int row = id / 48, ch = id - row * 48; *(LAS u32x4*)(RAW + row * 392 + (ch >> 4) * 128 + (ch & 15) * 8) = rv[it]; }
            }
        }
        if (w == 0) {
            const int i = lane; float g = 0.f, beta = 0.f;
            if (i < nv) {
                const float a = bf2f(HIN[(size_t)(rb + i) * HINW + 2048 + h]), bt = bf2f(HIN[(size_t)(rb + i) * HINW + 2052 + h]);
                const float xx = a + P.in[21][h];
                const float ex = __expf(xx);
                const float sp = xx > 20.f ? xx : (ex < 1e-3f ? ex * (1.0f - 0.5f * ex + 0.33333334f * ex * ex) : __logf(1.0f + ex));
                g = -__expf(P.in[20][h]) * sp;
                beta = 1.0f / (1.0f + __expf(-bt));
            }
            float G = g;
#pragma unroll
            for (int o = 1; o < 64; o <<= 1) { const float t = __shfl_up(G, o); if (lane >= o) G += t; }
            const float Gl = __shfl(G, 63);
            SG[i] = G; SEG[i] = __expf(G); SBETA[i] = beta; SKDEC[i] = __expf(Gl - G);
            if (lane == 0) *GLo = Gl;
        }
        __syncthreads();
        if (!(skipm & 2)) for (int task = tid; task < 1536; task += 512) {
            const int seg = task / 384, colg = task - seg * 384, part = colg >> 7, cc = colg & 127;
            const int col = part * 512 + h * 128 + cc;
            const float w0 = convw[col], w1 = convw[1536 + col], w2 = convw[3072 + col], w3 = convw[4608 + col];
            const int i0 = seg * 16;
            LAS bf16_t* rp = RAW + i0 * 392 + colg;
            float xm3 = bf2f(rp[0]), xm2 = bf2f(rp[392]), xm1 = bf2f(rp[784]);
#pragma unroll
            for (int rr = 0; rr < 16; ++rr) {
                const float x = bf2f(rp[(rr + 3) * 392]);
                float y = w0 * xm3 + w1 * xm2 + w2 * xm1 + w3 * x;
                y = (i0 + rr) < nv ? silu_f(y) : 0.f;
                XT[(i0 + rr) * 384 + colg] = y;
                xm3 = xm2; xm2 = xm1; xm1 = x;
            }
        }
        __syncthreads();
        if (!(skipm & 4))
#pragma unroll 2
        for (int rr = 0; rr < 8; ++rr) {
            const int i = w * 8 + rr;
            const float q0 = XT[i * 384 + lane], q1 = XT[i * 384 + 64 + lane], k0 = XT[i * 384 + 128 + lane], k1 = XT[i * 384 + 192 + lane];
            const float v0 = XT[i * 384 + 256 + lane], v1 = XT[i * 384 + 320 + lane];
            const float sq = wsum(q0 * q0 + q1 * q1), sk = wsum(k0 * k0 + k1 * k1);
            const float rq = rsqrtf(sq + EPS) * 0.08838834764831845f, rk = rsqrtf(sk + EPS);
            const float qa = q0 * rq, qb = q1 * rq, ka = k0 * rk, kb = k1 * rk;
            const float eg = SEG[i], beta = SBETA[i];
            QB[i * 136 + lane] = f2bf(qa); QB[i * 136 + 64 + lane] = f2bf(qb);
            KB[i * 136 + lane] = f2bf(ka); KB[i * 136 + 64 + lane] = f2bf(kb);
            QDo[i * 128 + lane] = f2bf(qa * eg); QDo[i * 128 + 64 + lane] = f2bf(qb * eg);
            XT[i * 384 + 128 + lane] = beta * eg * ka; XT[i * 384 + 192 + lane] = beta * eg * kb;
            XT[i * 384 + 256 + lane] = beta * v0; XT[i * 384 + 320 + lane] = beta * v1;
        }
        __syncthreads();
        {
            const int d = tid & 127;
#pragma unroll
            for (int t2 = 0; t2 < 2; ++t2) {
                const int i8 = (tid >> 7) + 4 * t2;
                float kv[8];
#pragma unroll
                for (int k = 0; k < 8; ++k) kv[k] = bf2f(KB[(8 * i8 + k) * 136 + d]) * SKDEC[8 * i8 + k];
                u32x4 wv; wv.x = cvt_pk_bf16(kv[0], kv[1]); wv.y = cvt_pk_bf16(kv[2], kv[3]); wv.z = cvt_pk_bf16(kv[4], kv[5]); wv.w = cvt_pk_bf16(kv[6], kv[7]);
                *(u32x4*)(KTTo + d * 64 + 8 * i8) = wv;
            }
        }
        {
            const int mi = w >> 1;
#pragma unroll
            for (int t2 = 0; t2 < 2; ++t2) {
                const int nj = 2 * (w & 1) + t2;
                f32x4 akk = {0.f, 0.f, 0.f, 0.f}, aqk = {0.f, 0.f, 0.f, 0.f};
#pragma unroll
                for (int ks = 0; ks < 4; ++ks) {
                    const bf16x8 ak = *(const LAS bf16x8*)(KB + (16 * mi + fr) * 136 + 32 * ks + 8 * fq);
                    const bf16x8 aq = *(const LAS bf16x8*)(QB + (16 * mi + fr) * 136 + 32 * ks + 8 * fq);
                    const bf16x8 bk = *(const LAS bf16x8*)(KB + (16 * nj + fr) * 136 + 32 * ks + 8 * fq);
                    akk = mfma16(ak, bk, akk); aqk = mfma16(aq, bk, aqk);
                }
                const int colj = 16 * nj + fr; const float Gj = SG[colj];
#pragma unroll
                for (int j = 0; j < 4; ++j) {
                    const int rowi = 16 * mi + 4 * fq + j; const float Gi = SG[rowi];
                    const float dec = __expf(fminf(Gi - Gj, 0.f));
                    if (colj < rowi) XT[rowi * 384 + colj] = SBETA[rowi] * akk[j] * dec;
                    QKo[rowi * 64 + colj] = f2bf(colj <= rowi ? aqk[j] * dec : 0.f);
                }
            }
        }
        __syncthreads();
        if (tid < 256 && !(skipm & 1)) {
            const int cidx = 128 + tid;
            float sol[64];
            LAS float* XA = XT; LAS float* XB = XT + 32 * 384;
            asm volatile("" : "+v"(XA)); asm volatile("" : "+v"(XB));
#pragma unroll
            for (int i = 0; i < 64; ++i) {
                LAS float* rowp = i < 32 ? XA + i * 384 : XB + (i - 32) * 384;
                float a0 = rowp[cidx], a1 = 0.f;
                const int arow = __builtin_bit_cast(int, rowp[lane]);
#pragma unroll
                for (int j4 = 0; j4 < (i + 3) / 4; ++j4) {
                    float aj[4];
#pragma unroll
                    for (int k = 0; k < 4; ++k) aj[k] = __builtin_bit_cast(float, __builtin_amdgcn_readlane(arow, (4 * j4 + k) & 63));
#pragma unroll
                    for (int k = 0; k < 4; ++k) { const int j = 4 * j4 + k; if (j < i) { if (j & 1) a1 -= aj[k] * sol[j]; else a0 -= aj[k] * sol[j]; } }
                }
                sol[i] = a0 + a1;
            }
            if (tid < 128) {
#pragma unroll
                for (int i = 0; i < 64; ++i) WKo[i * 128 + tid] = f2bf(sol[i]);
            } else {
                const int e = tid - 128;
#pragma unroll
                for (int i8 = 0; i8 < 8; ++i8) {
                    u32x4 wv; wv.x = cvt_pk_bf16(sol[8 * i8], sol[8 * i8 + 1]); wv.y = cvt_pk_bf16(sol[8 * i8 + 2], sol[8 * i8 + 3]);
                    wv.z = cvt_pk_bf16(sol[8 * i8 + 4], sol[8 * i8 + 5]); wv.w = cvt_pk_bf16(sol[8 * i8 + 6], sol[8 * i8 + 7]);
                    *(u32x4*)(UTo + e * 64 + 8 * i8) = wv;
                }
            }
        }
        asm volatile("s_waitcnt vmcnt(0)" ::: "memory");
        __syncthreads();
        if (tid == 0 && !(skipm & 8)) __hip_atomic_store(FLG + item, 1u, __ATOMIC_RELEASE, __HIP_MEMORY_SCOPE_AGENT);
    }
}

struct ScanA { bf16x8 wk[4], qd[4]; bf16x4 u[4]; };
struct ScanB { bf16x8 qk[2], kt[2]; };
__device__ __forceinline__ void scan_load_a(ScanA& F, const Params& P, int item, int cb, int eh, int fr, int fq) {
    const unsigned char* dob = (const unsigned char*)P.out;
    const bf16_t* WK = (const bf16_t*)(dob + DO_WK) + (size_t)item * 8192;
    const bf16_t* QD = (const bf16_t*)(dob + DO_QD) + (size_t)item * 8192;
    const bf16_t* UT = (const bf16_t*)(dob + DO_UT) + (size_t)item * 8192;
#pragma unroll
    for (int eb = 0; eb < 4; ++eb) F.u[eb] = *(const bf16x4*)(UT + (16 * (4 * eh + eb) + fr) * 64 + 16 * cb + 4 * fq);
#pragma unroll
    for (int ks = 0; ks < 4; ++ks) { F.wk[ks] = *(const bf16x8*)(WK + (16 * cb + fr) * 128 + 32 * ks + 8 * fq); F.qd[ks] = *(const bf16x8*)(QD + (16 * cb + fr) * 128 + 32 * ks + 8 * fq); }
}
__device__ __forceinline__ void scan_load_b(ScanB& F, const Params& P, int item, int cb, int eh, int w, int fr, int fq) {
    const bf16_t* KTT = (const bf16_t*)(P.ws + OFF_KTT) + (size_t)item * 8192;
    const bf16_t* QK = (const bf16_t*)(P.ws + OFF_QK) + (size_t)item * 4096;
#pragma unroll
    for (int ks = 0; ks < 2; ++ks) { F.qk[ks] = *(const bf16x8*)(QK + (16 * cb + fr) * 64 + 32 * ks + 8 * fq); F.kt[ks] = *(const bf16x8*)(KTT + (16 * w + fr) * 64 + 32 * ks + 8 * fq); }
}

__device__ __forceinline__ int scan_wait(const unsigned* FLG, int first, int maxcount, int w, int lane, LAS int* word) {
    if (w == 0) {
        int lead;
        for (;;) {
            unsigned f = 0u;
            if (lane < maxcount) f = __hip_atomic_load(FLG + first + lane, __ATOMIC_RELAXED, __HIP_MEMORY_SCOPE_AGENT);
            const unsigned long long m = __ballot(f != 0u);
            lead = __builtin_ctzll(~m);
            if (lead >= 1) break;
            __builtin_amdgcn_s_sleep(4);
        }
        __builtin_amdgcn_fence(__ATOMIC_ACQUIRE, "agent");
        if (lane == 0) *word = lead;
    }
    __syncthreads();
    return *word;
}
constexpr int SCAN_WIN = 16;
__device__ __forceinline__ void phase_scan(const Params& P, LAS unsigned char* L, const int tid, const int bid) {
    const int w = tid >> 6, lane = tid & 63, fr = lane & 15, fq = lane >> 4;
    const unsigned* FLG = (const unsigned*)(P.ws + OFF_FLG);
    const int cb = w & 3, eh = w >> 2;
    LAS bf16_t* WT = (LAS bf16_t*)(L + 69632);
    LAS float* SSB = (LAS float*)(L + 88064);
    const bf16_t* HIN = (const bf16_t*)(P.ws + OFF_GU);
    bf16_t* O = (bf16_t*)(P.ws + OFF_H);
    for (int sh = bid; sh < 64; sh += gridDim.x) {
        const int s = sh >> 2, h = sh & 3;
        const bool sample = s >= 8;
        const int nch = sample ? 1 : 65;
        const int item0 = sample ? 2080 + (s - 8) * 4 + h : s * 260 + h * 65;
        const int rb0 = sample ? NP + (s - 8) * 64 : s * LSEQ;
        f32x4 sacc[8];
        if (sample) {
            const float* S0 = P.in[4] + ((size_t)(s - 8) * 4 + h) * 16384;
#pragma unroll
            for (int eb = 0; eb < 8; ++eb)
#pragma unroll
                for (int j = 0; j < 4; ++j) sacc[eb][j] = S0[(16 * w + 4 * fq + j) * 128 + 16 * eb + fr];
        } else {
#pragma unroll
            for (int eb = 0; eb < 8; ++eb) sacc[eb] = (f32x4){0.f, 0.f, 0.f, 0.f};
        }
        __syncthreads();
        {
            LAS bf16_t* St = (LAS bf16_t*)L;
#pragma unroll
            for (int eb = 0; eb < 8; ++eb) { u32x2 wv; wv.x = cvt_pk_bf16(sacc[eb][0], sacc[eb][1]); wv.y = cvt_pk_bf16(sacc[eb][2], sacc[eb][3]);
                *(LAS u32x2*)(St + (16 * eb + fr) * 136 + 16 * w + 4 * fq) = wv; }
        }
        LAS int* wword = (LAS int*)(L + 88064);
        int ready = scan_wait(FLG, item0, nch < SCAN_WIN ? nch : SCAN_WIN, w, lane, wword) - 1;
        ScanA F; scan_load_a(F, P, item0, cb, eh, fr, fq);
        __syncthreads();
#pragma unroll 1
        for (int n = 0; n < nch; ++n) {
            const int cur = n & 1;
            LAS bf16_t* Sc = (LAS bf16_t*)(L + cur * 34816);
            LAS bf16_t* Sn = (LAS bf16_t*)(L + (cur ^ 1) * 34816);
            const int rb = rb0 + 64 * n; int nv = sample ? 64 : LSEQ - 64 * n; if (nv > 64) nv = 64;
            if (n + 1 < nch && n + 1 > ready) { const int cnt = (nch - (n + 1)) < SCAN_WIN ? (nch - (n + 1)) : SCAN_WIN; ready = n + scan_wait(FLG, item0 + n + 1, cnt, w, lane, wword); }
            const float egl = __expf(((const float*)(P.ws + OFF_GL))[item0 + n]);
            const int orow = tid >> 3, oseg = tid & 7;
            ScanB G; scan_load_b(G, P, item0 + n, cb, eh, w, fr, fq);
            ScanA Fn;
            if (n + 1 < nch) scan_load_a(Fn, P, item0 + n + 1, cb, eh, fr, fq); else Fn = F;
            f32x4 wacc[4], oacc[4];
#pragma unroll
            for (int eb = 0; eb < 4; ++eb) { wacc[eb] = (f32x4){0.f, 0.f, 0.f, 0.f}; oacc[eb] = (f32x4){0.f, 0.f, 0.f, 0.f}; }
#pragma unroll
            for (int ks = 0; ks < 4; ++ks)
#pragma unroll
                for (int eb = 0; eb < 4; ++eb) {
                    const bf16x8 b = *(const LAS bf16x8*)(Sc + (16 * (4 * eh + eb) + fr) * 136 + 32 * ks + 8 * fq);
                    wacc[eb] = mfma16(F.wk[ks], b, wacc[eb]); oacc[eb] = mfma16(F.qd[ks], b, oacc[eb]);
                }
#pragma unroll
            for (int eb = 0; eb < 4; ++eb) {
                const float w0 = bf2f((bf16_t)F.u[eb][0]) - wacc[eb][0], w1 = bf2f((bf16_t)F.u[eb][1]) - wacc[eb][1];
                const float w2 = bf2f((bf16_t)F.u[eb][2]) - wacc[eb][2], w3 = bf2f((bf16_t)F.u[eb][3]) - wacc[eb][3];
                u32x2 wv; wv.x = cvt_pk_bf16(w0, w1); wv.y = cvt_pk_bf16(w2, w3);
                *(LAS u32x2*)(WT + (16 * (4 * eh + eb) + fr) * 72 + 16 * cb + 4 * fq) = wv;
            }
            __syncthreads();
            u32x4 zr0 = (u32x4){0u, 0u, 0u, 0u}, zr1 = zr0;
            if (orow < nv) { const bf16_t* zp = HIN + (size_t)(rb + orow) * HINW + 1536 + h * 128 + 16 * oseg; zr0 = *(const u32x4*)zp; zr1 = *(const u32x4*)(zp + 8); }
#pragma unroll
            for (int ks = 0; ks < 2; ++ks)
#pragma unroll
                for (int eb = 0; eb < 4; ++eb) {
                    const bf16x8 b = *(const LAS bf16x8*)(WT + (16 * (4 * eh + eb) + fr) * 72 + 32 * ks + 8 * fq);
                    oacc[eb] = mfma16(G.qk[ks], b, oacc[eb]);
                }
#pragma unroll
            for (int eb = 0; eb < 8; ++eb) {
                sacc[eb] = sacc[eb] * egl;
#pragma unroll
                for (int ks = 0; ks < 2; ++ks) {
                    const bf16x8 b = *(const LAS bf16x8*)(WT + (16 * eb + fr) * 72 + 32 * ks + 8 * fq);
                    sacc[eb] = mfma16(G.kt[ks], b, sacc[eb]);
                }
                u32x2 wv; wv.x = cvt_pk_bf16(sacc[eb][0], sacc[eb][1]); wv.y = cvt_pk_bf16(sacc[eb][2], sacc[eb][3]);
                *(LAS u32x2*)(Sn + (16 * eb + fr) * 136 + 16 * w + 4 * fq) = wv;
            }
            {
                LAS float* OT = (LAS float*)(L + 88576);
#pragma unroll
                for (int eb = 0; eb < 4; ++eb)
#pragma unroll
                    for (int j = 0; j < 4; ++j) OT[(16 * cb + 4 * fq + j) * 132 + 16 * (4 * eh + eb) + fr] = oacc[eb][j];
            }
            __syncthreads();
            {
                const LAS float* OT = (const LAS float*)(L + 88576) + orow * 132 + 16 * oseg;
                f32x4 ov[4];
#pragma unroll
                for (int k = 0; k < 4; ++k) ov[k] = *(const LAS f32x4*)(OT + 4 * k);
                float ssq = 0.f;
#pragma unroll
                for (int k = 0; k < 4; ++k) ssq += ov[k][0] * ov[k][0] + ov[k][1] * ov[k][1] + ov[k][2] * ov[k][2] + ov[k][3] * ov[k][3];
                ssq += __shfl_xor(ssq, 1); ssq += __shfl_xor(ssq, 2); ssq += __shfl_xor(ssq, 4);
                const float r = rsqrtf(ssq * (1.0f / 128.0f) + EPS);
                if (orow < nv) {
                    const float* gn = P.in[22] + 16 * oseg;
                    unsigned zz[8] = {zr0.x, zr0.y, zr0.z, zr0.w, zr1.x, zr1.y, zr1.z, zr1.w};
                    unsigned ow[8];
#pragma unroll
                    for (int k = 0; k < 8; ++k) {
                        const float z0 = __uint_as_float(zz[k] << 16), z1 = __uint_as_float(zz[k] & 0xffff0000u);
                        const float o0 = ov[k >> 1][(k & 1) * 2] * r * gn[2 * k] * silu_f(z0), o1 = ov[k >> 1][(k & 1) * 2 + 1] * r * gn[2 * k + 1] * silu_f(z1);
                        ow[k] = cvt_pk_bf16(o0, o1);
                    }
                    bf16_t* op = O + (size_t)(rb + orow) * 1024 + h * 128 + 16 * oseg;
                    *(u32x4*)op = (u32x4){ow[0], ow[1], ow[2], ow[3]}; *(u32x4*)(op + 8) = (u32x4){ow[4], ow[5], ow[6], ow[7]};
                }
            }
            F = Fn;
        }
        float* So = P.out + (sample ? OFF_SS + ((size_t)(s - 8) * 4 + h) * 16384 : OFF_PS + ((size_t)s * 4 + h) * 16384);
#pragma unroll
        for (int eb = 0; eb < 8; ++eb)
#pragma unroll
            for (int j = 0; j < 4; ++j) So[(16 * w + 4 * fq + j) * 128 + 16 * eb + fr] = sacc[eb][j];
    }
}

__device__ __forceinline__ void phase_mlaprep(const Params& P, const int tid, const int bid) {
    const int lane = tid & 63;
    const bf16_t* HIN = (const bf16_t*)(P.ws + OFF_GU);
    bf16_t* CQ = (bf16_t*)(P.ws + OFF_CQ); bf16_t* CKVA = (bf16_t*)(P.ws + OFF_CKVA); bf16_t* KRA = (bf16_t*)(P.ws + OFF_KRA);
    const float2* rope = (const float2*)(P.ws + OFF_ROPE);
    const int wv = bid * 8 + (tid >> 6), nw = gridDim.x * 8;
    constexpr int T0 = MT, T1 = T0 + 8192, T2 = T1 + (MKP - MK), T3 = T2 + (MP - MT), T4 = T3 + 48;
    for (int task = wv; task < T4; task += nw) {
        if (task < T0) {
            const int r = task;
            const bf16_t* hr = HIN + (size_t)r * HINW;
            int pos, keyrow; float* ockv; float* okr;
            if (r < NP) { pos = r % LSEQ; keyrow = r; ockv = P.out + OFF_PCKV + (size_t)r * 256; okr = P.out + OFF_PKR + (size_t)r * 32; }
            else { const int q = r - NP, b = q >> 6, t = q & 63; pos = 1024 + t; keyrow = NP + b * 1088 + 1024 + t; ockv = P.out + OFF_SCKV + (size_t)q * 256; okr = P.out + OFF_SKR + (size_t)q * 32; }
            {
                float v[6]; float ss = 0.f;
#pragma unroll
                for (int k = 0; k < 6; ++k) { v[k] = bf2f(hr[2056 + lane + 64 * k]); ss += v[k] * v[k]; }
                ss = wsum(ss); const float rs = rsqrtf(ss * (1.0f / 384.0f) + EPS);
#pragma unroll
                for (int k = 0; k < 6; ++k) CQ[(size_t)r * 384 + lane + 64 * k] = f2bf(v[k] * rs * P.in[23][lane + 64 * k]);
            }
            {
                float v[4]; float ss = 0.f;
#pragma unroll
                for (int k = 0; k < 4; ++k) { v[k] = bf2f(hr[2440 + lane + 64 * k]); ss += v[k] * v[k]; }
                ss = wsum(ss); const float rs = rsqrtf(ss * (1.0f / 256.0f) + EPS);
#pragma unroll
                for (int k = 0; k < 4; ++k) { const float y = v[k] * rs * P.in[25][lane + 64 * k]; ockv[lane + 64 * k] = y; CKVA[(size_t)keyrow * 256 + lane + 64 * k] = f2bf(y); }
            }
            {
                const float v = lane < 32 ? bf2f(hr[2696 + lane]) : 0.f;
                const float ss = wsum(v * v); const float rs = rsqrtf(ss * (1.0f / 32.0f) + EPS);
                const float y = lane < 32 ? v * rs * P.in[30][lane] : 0.f;
                const float pr = __shfl_xor(y, 16);
                const float2 cs = rope[pos * 16 + (lane & 15)];
                const float o = (lane & 16) ? (y * cs.x + pr * cs.y) : (y * cs.x - pr * cs.y);
                if (lane < 32) { okr[lane] = o; KRA[(size_t)keyrow * 32 + lane] = f2bf(o); }
            }
        } else if (task < T1) {
            const int q = task - T0, b = q >> 10, j = q & 1023, keyrow = NP + b * 1088 + j;
            const float* sc = P.in[2] + ((size_t)b * 1024 + j) * 256;
#pragma unroll
            for (int k = 0; k < 4; ++k) CKVA[(size_t)keyrow * 256 + lane + 64 * k] = f2bf(sc[lane + 64 * k]);
            if (lane < 32) KRA[(size_t)keyrow * 32 + lane] = f2bf(P.in[3][((size_t)b * 1024 + j) * 32 + lane]);
        } else if (task < T2) {
            const int keyrow = MK + (task - T1);
#pragma unroll
            for (int k = 0; k < 4; ++k) CKVA[(size_t)keyrow * 256 + lane + 64 * k] = 0;
            if (lane < 32) KRA[(size_t)keyrow * 32 + lane] = 0;
        } else if (task < T3) {
            const int r = MT + (task - T2);
#pragma unroll
            for (int k = 0; k < 6; ++k) CQ[(size_t)r * 384 + lane + 64 * k] = 0;
        } else {
            const int k3 = task - T3, s = k3 / 3, i = k3 - 3 * s;
            const int srow = s < 8 ? s * LSEQ + (LSEQ - 3) + i : NP + (s - 8) * 64 + 61 + i;
            float* dst = s < 8 ? P.out + OFF_PCONV + ((size_t)s * 3 + i) * 1536 : P.out + OFF_SCONV + ((size_t)(s - 8) * 3 + i) * 1536;
            for (int k = 0; k < 24; ++k) dst[lane + 64 * k] = bf2f(HIN[(size_t)srow * HINW + lane + 64 * k]);
        }
    }
}

__device__ __forceinline__ void phase_attn(const Params& P, LAS unsigned char* L, const int tid, const int bid) {
    const int w = tid >> 6, lane = tid & 63, fr = lane & 15, fq = lane >> 4;
    const bf16_t* Q = (const bf16_t*)(P.ws + OFF_Q); const bf16_t* KN = (const bf16_t*)(P.ws + OFF_KN);
    const bf16_t* KRA = (const bf16_t*)(P.ws + OFF_KRA); const bf16_t* VT = (const bf16_t*)(P.ws + OFF_VT);
    bf16_t* O = (bf16_t*)(P.ws + OFF_H);
    constexpr int BUFB = 22528;
    const int krow = tid >> 3, kch = tid & 7;
    const int rrow = (tid & 255) >> 2, rch = tid & 3;
    const int G_ = (int)gridDim.x;
    for (int rnd = 0; rnd * G_ < 1088 + 64; ++rnd) {
        const int idx = rnd * G_ + ((rnd & 1) ? G_ - 1 - bid : bid);
        if (idx >= 1088 + 64) continue;
        const int item = idx < 64 ? 1088 + idx : idx - 64;
        int b, head, rowq, kb, kendb; int kend[2]; bool act[2];
        if (item < 1088) {
            const int t = 16 - item / 64, bh = item & 63; b = bh >> 3; head = bh & 7;
            const int q0 = 256 * t + 32 * w; rowq = b * LSEQ + q0; kb = b * LSEQ;
#pragma unroll
            for (int g = 0; g < 2; ++g) { act[g] = (q0 + 16 * g) < LSEQ; kend[g] = 16 + 64 * (((q0 + 16 * g - 16) >> 6) + 1); }
            int lastq = 256 * t + 255; if (lastq > LSEQ - 1) lastq = LSEQ - 1;
            kendb = 16 + 64 * (((lastq - 16) >> 6) + 1);
        } else {
            const int j = item - 1088; b = j >> 3; head = j & 7; rowq = NP + b * 64 + 32 * w; kb = NP + b * 1088; kendb = 1088;
            act[0] = act[1] = w < 2; kend[0] = kend[1] = 1088;
        }
        const int ntile = (kendb + 63) >> 6;
        bf16x8 qf[2][3];
#pragma unroll
        for (int g = 0; g < 2; ++g) {
            if (act[g]) {
                const bf16_t* qrow = Q + (size_t)(rowq + 16 * g + fr) * 768;
                qf[g][0] = *(const bf16x8*)(qrow + head * 64 + 8 * fq); qf[g][1] = *(const bf16x8*)(qrow + head * 64 + 32 + 8 * fq); qf[g][2] = *(const bf16x8*)(qrow + 512 + head * 32 + 8 * fq);
            } else { qf[g][0] = qf[g][1] = qf[g][2] = (bf16x8){0, 0, 0, 0, 0, 0, 0, 0}; }
        }
        f32x4 o[2][4];
#pragma unroll
        for (int g = 0; g < 2; ++g)
#pragma unroll
            for (int d = 0; d < 4; ++d) o[g][d] = (f32x4){0.f, 0.f, 0.f, 0.f};
        float mrun[2] = {-1e30f, -1e30f}, lrun[2] = {0.f, 0.f};
        const bf16_t* knp = KN + (size_t)(kb + krow) * 512 + head * 64 + 8 * kch;
        const bf16_t* krp = KRA + (size_t)(kb + rrow) * 32 + 8 * rch;
        const bf16_t* vtp = VT + (size_t)(head * 64 + krow) * MKP + kb + 8 * kch;
        u32x4 rk = *(const u32x4*)knp, rv = *(const u32x4*)vtp, rr = (u32x4){0u, 0u, 0u, 0u};
        if (tid < 256) rr = *(const u32x4*)krp;
        __syncthreads();
        *(LAS u32x4*)(L + (krow * 104 + 8 * kch) * 2) = rk;
        *(LAS u32x4*)(L + 13312 + (krow * 72 + 8 * kch) * 2) = rv;
        if (tid < 256) *(LAS u32x4*)(L + (rrow * 104 + 64 + 8 * rch) * 2) = rr;
        __syncthreads();
#pragma unroll 1
        for (int kt = 0; kt < ntile; ++kt) {
            const int cur = kt & 1;
            const bool more = kt + 1 < ntile;
            if (more) {
                rk = *(const u32x4*)(knp + (size_t)(kt + 1) * 64 * 512);
                rv = *(const u32x4*)(vtp + (kt + 1) * 64);
                if (tid < 256) rr = *(const u32x4*)(krp + (size_t)(kt + 1) * 64 * 32);
            }
            const bool do0 = act[0] && 64 * kt < kend[0], do1 = act[1] && 64 * kt < kend[1];
            if (do0 || do1) {
                LAS bf16_t* Kt = (LAS bf16_t*)(L + cur * BUFB);
                LAS bf16_t* Vt = (LAS bf16_t*)(L + cur * BUFB + 13312);
                f32x4 sc[2][4];
                __builtin_amdgcn_s_setprio(1);
#pragma unroll
                for (int i = 0; i < 4; ++i) {
                    sc[0][i] = (f32x4){0.f, 0.f, 0.f, 0.f}; sc[1][i] = (f32x4){0.f, 0.f, 0.f, 0.f};
#pragma unroll
                    for (int ks = 0; ks < 3; ++ks) {
                        const bf16x8 a = *(const LAS bf16x8*)(Kt + (16 * i + fr) * 104 + 32 * ks + 8 * fq);
                        sc[0][i] = mfma16(a, qf[0][ks], sc[0][i]);
                        sc[1][i] = mfma16(a, qf[1][ks], sc[1][i]);
                    }
                }
                __builtin_amdgcn_s_setprio(0);
                bf16x8 pf[2][2];
#pragma unroll
                for (int g = 0; g < 2; ++g) {
                    if (64 * kt + 64 > kend[g]) {
#pragma unroll
                        for (int i = 0; i < 4; ++i)
#pragma unroll
                            for (int j = 0; j < 4; ++j) if (64 * kt + 16 * i + 4 * fq + j >= kend[g]) sc[g][i][j] = -1e30f;
                    }
                    float mx = -1e30f;
#pragma unroll
                    for (int i = 0; i < 4; ++i) mx = fmaxf(mx, fmaxf(fmaxf(sc[g][i][0], sc[g][i][1]), fmaxf(sc[g][i][2], sc[g][i][3])));
                    mx = fmaxf(mx, __shfl_xor(mx, 16)); mx = fmaxf(mx, __shfl_xor(mx, 32));
                    const float mn = fmaxf(mrun[g], mx);
                    const float alpha = __builtin_amdgcn_exp2f(mrun[g] - mn);
                    mrun[g] = mn;
                    float ls = 0.f;
#pragma unroll
                    for (int i = 0; i < 4; ++i)
#pragma unroll
                        for (int j = 0; j < 4; ++j) { const float p = __builtin_amdgcn_exp2f(sc[g][i][j] - mn); sc[g][i][j] = p; ls += p; }
                    lrun[g] = lrun[g] * alpha + ls;
#pragma unroll
                    for (int d = 0; d < 4; ++d) o[g][d] = o[g][d] * alpha;
#pragma unroll
                    for (int s2 = 0; s2 < 2; ++s2) {
                        u32x4 pw; pw.x = cvt_pk_bf16(sc[g][2 * s2][0], sc[g][2 * s2][1]); pw.y = cvt_pk_bf16(sc[g][2 * s2][2], sc[g][2 * s2][3]);
                        pw.z = cvt_pk_bf16(sc[g][2 * s2 + 1][0], sc[g][2 * s2 + 1][1]); pw.w = cvt_pk_bf16(sc[g][2 * s2 + 1][2], sc[g][2 * s2 + 1][3]);
                        pf[g][s2] = __builtin_bit_cast(bf16x8, pw);
                    }
                }
                __builtin_amdgcn_s_setprio(1);
#pragma unroll
                for (int d = 0; d < 4; ++d)
#pragma unroll
                    for (int s2 = 0; s2 < 2; ++s2) {
                        const u32x2 lo = *(const LAS u32x2*)(Vt + (16 * d + fr) * 72 + 32 * s2 + 4 * fq);
                        const u32x2 hi = *(const LAS u32x2*)(Vt + (16 * d + fr) * 72 + 32 * s2 + 16 + 4 * fq);
                        u32x4 av; av.x = lo.x; av.y = lo.y; av.z = hi.x; av.w = hi.y;
                        const bf16x8 avb = __builtin_bit_cast(bf16x8, av);
                        o[0][d] = mfma16(avb, pf[0][s2], o[0][d]);
                        o[1][d] = mfma16(avb, pf[1][s2], o[1][d]);
                    }
                __builtin_amdgcn_s_setprio(0);
            }
            if (more) {
                LAS unsigned char* nb = L + (cur ^ 1) * BUFB;
                *(LAS u32x4*)(nb + (krow * 104 + 8 * kch) * 2) = rk;
                *(LAS u32x4*)(nb + 13312 + (krow * 72 + 8 * kch) * 2) = rv;
                if (tid < 256) *(LAS u32x4*)(nb + (rrow * 104 + 64 + 8 * rch) * 2) = rr;
            }
            __syncthreads();
        }
#pragma unroll
        for (int g = 0; g < 2; ++g) {
            if (act[g]) {
                float lt = lrun[g]; lt += __shfl_xor(lt, 16); lt += __shfl_xor(lt, 32);
                const float inv = 1.0f / lt;
#pragma unroll
                for (int d = 0; d < 4; ++d) {
                    u32x2 wv; wv.x = cvt_pk_bf16(o[g][d][0] * inv, o[g][d][1] * inv); wv.y = cvt_pk_bf16(o[g][d][2] * inv, o[g][d][3] * inv);
                    *(u32x2*)(O + (size_t)(rowq + 16 * g + fr) * 1024 + 512 + head * 64 + 16 * d + 4 * fq) = wv;
                }
            }
        }
    }
}

__device__ __forceinline__ void phase_sconv(const Params& P, const int tid, const int bid) {
    const int lane = tid & 63;
    const bf16_t* Pb = (const bf16_t*)(P.ws + OFF_P); const bf16_t* BG = (const bf16_t*)(P.ws + OFF_BG);
    bf16_t* A2 = (bf16_t*)(P.ws + OFF_H);
    const float* cw = P.in[32];
    const int wv = bid * 8 + (tid >> 6), nw = gridDim.x * 8;
    const int c0 = lane * 16;
    const int R = (MP + nw - 1) / nw, rbeg = wv * R, rend = (rbeg + R) < MP ? (rbeg + R) : MP;
    float w0[16], w1[16], w2[16];
#pragma unroll
    for (int k = 0; k < 16; ++k) { w0[k] = cw[c0 + k]; w1[k] = cw[1024 + c0 + k]; w2[k] = cw[2048 + c0 + k]; }
    float p0[16], p1[16];
#pragma unroll
    for (int k = 0; k < 16; ++k) { p0[k] = 0.f; p1[k] = 0.f; }
    bf16x8 nx0 = (bf16x8){0, 0, 0, 0, 0, 0, 0, 0}, nx1 = nx0, ng0 = nx0, ng1 = nx0;
    if (rbeg < rend && rbeg < MT) { nx0 = *(const bf16x8*)(Pb + (size_t)rbeg * 1024 + c0); nx1 = *(const bf16x8*)(Pb + (size_t)rbeg * 1024 + c0 + 8);
                                    ng0 = *(const bf16x8*)(BG + (size_t)rbeg * 1024 + c0); ng1 = *(const bf16x8*)(BG + (size_t)rbeg * 1024 + c0 + 8); }
    for (int r = rbeg; r < rend; ++r) {
        bf16_t* a2 = A2 + (size_t)r * 1024 + c0;
        const bf16x8 x0 = nx0, x1 = nx1, g0 = ng0, g1 = ng1;
        if (r + 1 < rend && r + 1 < MT) { nx0 = *(const bf16x8*)(Pb + (size_t)(r + 1) * 1024 + c0); nx1 = *(const bf16x8*)(Pb + (size_t)(r + 1) * 1024 + c0 + 8);
                                          ng0 = *(const bf16x8*)(BG + (size_t)(r + 1) * 1024 + c0); ng1 = *(const bf16x8*)(BG + (size_t)(r + 1) * 1024 + c0 + 8); }
        if (r >= MT) { *(u32x4*)a2 = (u32x4){0u, 0u, 0u, 0u}; *(u32x4*)(a2 + 8) = (u32x4){0u, 0u, 0u, 0u}; continue; }
        int t, b; const bool sample = r >= NP;
        if (!sample) { b = r / LSEQ; t = r - b * LSEQ; } else { const int q = r - NP; b = q >> 6; t = q & 63; }
        float p2[16], bg[16];
        {
#pragma unroll
            for (int k = 0; k < 8; ++k) { p2[k] = bf2f((bf16_t)x0[k]); p2[8 + k] = bf2f((bf16_t)x1[k]); bg[k] = bf2f((bf16_t)g0[k]); bg[8 + k] = bf2f((bf16_t)g1[k]); }
        }
        if (r == rbeg || t < 2) {
            if (t >= 1) {
                const bf16x8 x0 = *(const bf16x8*)(Pb + (size_t)(r - 1) * 1024 + c0), x1 = *(const bf16x8*)(Pb + (size_t)(r - 1) * 1024 + c0 + 8);
#pragma unroll
                for (int k = 0; k < 8; ++k) { p1[k] = bf2f((bf16_t)x0[k]); p1[8 + k] = bf2f((bf16_t)x1[k]); }
            } else {
#pragma unroll
                for (int k = 0; k < 16; ++k) p1[k] = sample ? P.in[6][((size_t)b * 2 + 1) * 1024 + c0 + k] : 0.f;
            }
            if (t >= 2) {
                const bf16x8 x0 = *(const bf16x8*)(Pb + (size_t)(r - 2) * 1024 + c0), x1 = *(const bf16x8*)(Pb + (size_t)(r - 2) * 1024 + c0 + 8);
#pragma unroll
                for (int k = 0; k < 8; ++k) { p0[k] = bf2f((bf16_t)x0[k]); p0[8 + k] = bf2f((bf16_t)x1[k]); }
            } else {
#pragma unroll
                for (int k = 0; k < 16; ++k) p0[k] = sample ? P.in[6][((size_t)b * 2 + t) * 1024 + c0 + k] : 0.f;
            }
        }
        float y[16];
#pragma unroll
        for (int k = 0; k < 16; ++k) y[k] = bg[k] * (w0[k] * p0[k] + w1[k] * p1[k] + w2[k] * p2[k]);
        u32x4 v0, v1;
        v0.x = cvt_pk_bf16(y[0], y[1]); v0.y = cvt_pk_bf16(y[2], y[3]); v0.z = cvt_pk_bf16(y[4], y[5]); v0.w = cvt_pk_bf16(y[6], y[7]);
        v1.x = cvt_pk_bf16(y[8], y[9]); v1.y = cvt_pk_bf16(y[10], y[11]); v1.z = cvt_pk_bf16(y[12], y[13]); v1.w = cvt_pk_bf16(y[14], y[15]);
        *(u32x4*)a2 = v0; *(u32x4*)(a2 + 8) = v1;
        const int tl = sample ? 64 : LSEQ;
        if (t >= tl - 2) {
            float* dst = P.out + (sample ? OFF_SSC : OFF_PSC) + ((size_t)b * 2 + (t - (tl - 2))) * 1024 + c0;
#pragma unroll
            for (int k = 0; k < 16; ++k) dst[k] = p2[k];
        }
#pragma unroll
        for (int k = 0; k < 16; ++k) { p0[k] = p1[k]; p1[k] = p2[k]; }
    }
}

__device__ __forceinline__ void phase_tap(const Params& P, int which, const int tid, const int bid) {
    float* dst = P.out + OFF_YS;
    for (int idx = bid * 512 + tid; idx < 512 * 1024; idx += gridDim.x * 512) {
        const int k = idx >> 10, c = idx & 1023;
        int row, keyrow;
        if (k < 256) { const int b = k >> 5, q = k & 31; row = b * LSEQ + (LSEQ - 32) + q; keyrow = row; }
        else { const int b = (k - 256) >> 5, q = (k - 256) & 31; row = NP + b * 64 + 32 + q; keyrow = NP + b * 1088 + 1024 + 32 + q; }
        float v = 0.f;
        if (which == 0) v = bf2f(((const bf16_t*)(P.ws + OFF_H))[(size_t)row * 1024 + c]);
        else if (which == 1) v = c < 768 ? bf2f(((const bf16_t*)(P.ws + OFF_Q))[(size_t)row * 768 + c]) : 0.f;
        else if (which == 2) v = c < 512 ? bf2f(((const bf16_t*)(P.ws + OFF_KN))[(size_t)keyrow * 512 + c]) : bf2f(((const bf16_t*)(P.ws + OFF_VT))[(size_t)(c - 512) * MKP + keyrow]);
        else if (which >= 8 && which <= 12) {
            const int it64 = idx >> 13, e = idx & 8191;
            const int s_ = it64 >> 3, h_ = (it64 >> 1) & 3, c_ = 63 + (it64 & 1);
            const int item = s_ * 260 + h_ * 65 + c_;
            const unsigned char* dob = (const unsigned char*)P.out;
            if (which == 8) v = bf2f(((const bf16_t*)(dob + DO_QD))[(size_t)item * 8192 + e]);
            else if (which == 9) v = e < 4096 ? bf2f(((const bf16_t*)(P.ws + OFF_QK))[(size_t)item * 4096 + e]) : ((const float*)(P.ws + OFF_GL))[item];
            else if (which == 10) v = bf2f(((const bf16_t*)(dob + DO_WK))[(size_t)item * 8192 + e]);
            else if (which == 11) v = bf2f(((const bf16_t*)(dob + DO_UT))[(size_t)item * 8192 + e]);
            else v = bf2f(((const bf16_t*)(P.ws + OFF_KTT))[(size_t)item * 8192 + e]);
        }
        else if (which == 6) v = c < 512 ? bf2f(((const bf16_t*)(P.ws + OFF_H))[(size_t)row * 1024 + c]) : 0.f;
        else if (which == 7) v = c >= 512 ? bf2f(((const bf16_t*)(P.ws + OFF_H))[(size_t)row * 1024 + c]) : 0.f;
        else if (which == 3) v = ((const float*)(P.ws + OFF_X))[(size_t)row * 1024 + c];
        else if (which == 4) v = bf2f(((const bf16_t*)(P.ws + OFF_P))[(size_t)row * 1024 + c]);
        else if (which == 5) v = bf2f(((const bf16_t*)(P.ws + OFF_BG))[(size_t)row * 1024 + c]);
        dst[idx] = v;
    }
}

__device__ __forceinline__ void panel_barrier(unsigned* cnt, unsigned want, const int tid) {
    asm volatile("s_waitcnt vmcnt(0)" ::: "memory");
    __syncthreads();
    if (tid == 0) {
        __builtin_amdgcn_fence(__ATOMIC_RELEASE, "agent");
        asm volatile("s_waitcnt vmcnt(0)" ::: "memory");
        (void)__hip_atomic_fetch_add(cnt, 1u, __ATOMIC_RELAXED, __HIP_MEMORY_SCOPE_AGENT);
        unsigned sp = 0;
        while (__hip_atomic_load(cnt, __ATOMIC_RELAXED, __HIP_MEMORY_SCOPE_AGENT) < want) { __builtin_amdgcn_s_sleep(2); if (++sp > (1u << 22)) break; }
        __builtin_amdgcn_fence(__ATOMIC_ACQUIRE, "agent");
        asm volatile("s_waitcnt vmcnt(0)" ::: "memory");
    }
    __syncthreads();
}
constexpr int MAIN_ROWS = 32768, MAIN_WGS = 244;
constexpr size_t OFF_PCNT = OFF_RSS + 16384;
template <class EpiC>
__device__ __forceinline__ void consumer_gemm(const Params& P, LAS unsigned char* L, const bf16_t* A, const bf16_t* Bt, int N, int K, const EpiC& EC, int down_arg, int slot, int tid, int bid, bool is_cons = true, int prod = 0) {
    if (!is_cons || bid < MAIN_WGS) { run_gemm(L, A, Bt, is_cons ? MAIN_ROWS : MP, N, K, EC, tid, bid, is_cons ? MAIN_WGS : (int)gridDim.x); return; }
    const int j = bid - MAIN_WGS, panel = 128 + (j >> 2), q = j & 3;
#pragma unroll 1
    for (int pass = 0; pass < (prod == 2 ? 2 : 1); ++pass) {
        const bool fin = pass == 1, dn = fin || prod == 0;
        if (fin) panel_barrier((unsigned*)(P.ws + OFF_PCNT) + (5 * 3 + (panel - 128)) * 64, 4u, tid);
        EpiAddX ED; ED.X = (float*)(P.ws + OFF_X); ED.scale = dn ? 0.5f : 1.0f; ED.out = P.out; ED.final_ = fin ? 1 : 0; ED.xb = dn ? (bf16_t*)(P.ws + OFF_H) : (bf16_t*)P.out; ED.rss = (float*)(P.ws + OFF_SPARE);
        const bf16_t* pA = dn ? (const bf16_t*)(P.ws + OFF_GU) : (const bf16_t*)(P.ws + OFF_H);
        const bf16_t* pB = dn ? (const bf16_t*)(P.ws + OFF_WD + (size_t)(fin ? 3 : down_arg) * SZ_WD) : (prod == 1 ? (const bf16_t*)(P.ws + OFF_WOUT) : (const bf16_t*)(P.ws + OFF_WSCOUT));
        run_gemm_strip(L, pA, pB, 1024, dn ? 2816 : 1024, ED, tid, panel, q, 4);
        if (!fin) {
            panel_barrier((unsigned*)(P.ws + OFF_PCNT) + (slot * 3 + (panel - 128)) * 64, 4u, tid);
            run_gemm_strip(L, A, Bt, N, K, EC, tid, panel, q, 4);
        }
    }
}

#define XB_TMO      128
#define XB_XCNT(j)  (256  + 64 * (j))
#define XB_XSUB(j)  (1280 + 64 * (j))
#define XB_XGEN(j)  (2304 + 64 * (j))
#define XB_TOP      3328
#define XB_TOPGEN   3392
#define XCD_BAR_WORDS 3456
#define XB_SPIN_CAP (1u << 18)
__device__ __forceinline__ unsigned xb_ld(unsigned* p)              { return __hip_atomic_load(p, __ATOMIC_RELAXED, __HIP_MEMORY_SCOPE_AGENT); }
__device__ __forceinline__ unsigned xb_add(unsigned* p, unsigned v) { return __hip_atomic_fetch_add(p, v, __ATOMIC_RELAXED, __HIP_MEMORY_SCOPE_AGENT); }
__device__ __forceinline__ unsigned xb_xcc_id() { return (unsigned)__builtin_amdgcn_s_getreg((3 << 11) | 20) & 0xFu; }
#define XB_SPIN(cond, bar) do { unsigned _sp = 0; while (cond) { __builtin_amdgcn_s_sleep(1); \
    if ((++_sp & 255u) == 0u) { if (xb_ld(&(bar)[XB_TMO])) break; if (_sp > XB_SPIN_CAP) { atomicAdd(&(bar)[XB_TMO], 1u); break; } } } } while (0)
struct XcdBarrier { unsigned* bar; unsigned x; volatile LAS unsigned* st; };
__device__ __forceinline__ XcdBarrier xcd_barrier_post(unsigned* bar, volatile LAS unsigned* st) {
    XcdBarrier b; b.bar = bar; b.x = xb_xcc_id(); b.st = st;
    if (threadIdx.x == 0) (void)xb_add(&bar[XB_XCNT(b.x)], 1u);
    return b;
}
__device__ __forceinline__ void xcd_barrier_complete(unsigned* bar, unsigned x, unsigned& nloc, unsigned& nx) {
    const unsigned G = gridDim.x * gridDim.y * gridDim.z;
    unsigned sum, cnt, mine, sp = 0u;
    for (;;) {
        sum = 0u; cnt = 0u; mine = 0u;
#pragma unroll
        for (unsigned j = 0; j < 16; ++j) { const unsigned c = xb_ld(&bar[XB_XCNT(j)]); sum += c; cnt += (c > 0u) ? 1u : 0u; mine = (j == x) ? c : mine; }
        if (sum == G) break;
        __builtin_amdgcn_s_sleep(1);
        if ((++sp & 255u) == 0u) { if (xb_ld(&bar[XB_TMO])) break; if (sp > XB_SPIN_CAP) { atomicAdd(&bar[XB_TMO], 1u); break; } }
    }
    nloc = mine > 0u ? mine : 1u; nx = cnt > 0u ? cnt : 1u;
}
__device__ __forceinline__ void xcd_barrier(const XcdBarrier& b) {
    asm volatile("s_waitcnt vmcnt(0)" ::: "memory");
    __syncthreads();
    if (threadIdx.x == 0) {
        unsigned* bar = b.bar;
        __builtin_amdgcn_s_waitcnt(0);
        unsigned nloc = b.st[0], nx = b.st[1];
        if (nloc == 0u) { xcd_barrier_complete(bar, b.x, nloc, nx); b.st[0] = nloc; b.st[1] = nx; }
        const unsigned old = xb_add(&bar[XB_XSUB(b.x)], 1u);
        const unsigned gen = old / nloc;
        if (old + 1u == (gen + 1u) * nloc) {
            __builtin_amdgcn_fence(__ATOMIC_RELEASE, "agent");
            asm volatile("s_waitcnt vmcnt(0)" ::: "memory");
            const unsigned og = xb_add(&bar[XB_TOP], 1u);
            const unsigned tg = og / nx;
            if (og + 1u == (tg + 1u) * nx) xb_add(&bar[XB_TOPGEN], 1u);
            else XB_SPIN(xb_ld(&bar[XB_TOPGEN]) == tg, bar);
            __builtin_amdgcn_fence(__ATOMIC_ACQUIRE, "agent");
            xb_add(&bar[XB_XGEN(b.x)], 1u);
            asm volatile("s_waitcnt vmcnt(0)" ::: "memory");
        } else {
            XB_SPIN(xb_ld(&bar[XB_XGEN(b.x)]) == gen, bar);
            __builtin_amdgcn_fence(__ATOMIC_ACQUIRE, "agent");
            asm volatile("s_waitcnt vmcnt(0)" ::: "memory");
        }
    }
    __syncthreads();
}

#ifndef DUP_PHASE
#define DUP_PHASE -1
#endif
constexpr int N_PHASES = 18;
#ifndef ONLY_KIND
#define ONLY_KIND -1
#endif
#ifndef K8SUB
#define K8SUB 7
#endif
#define BLK_ID blockIdx.x
#define EN(k) (ONLY_KIND < 0 || ONLY_KIND == (k))
__global__ __launch_bounds__(512, 2) void mega(Params P0, int ph_lo, int ph_hi) {
    extern __shared__ __attribute__((aligned(16))) unsigned char lds_raw[];
    LAS unsigned char* L = (LAS unsigned char*)lds_raw;
    cg::grid_group grid = cg::this_grid();
    volatile LAS unsigned* xbst = (volatile LAS unsigned*)(L + 152576);
    if (threadIdx.x == 0) { xbst[0] = 0u; xbst[1] = 0u; }
    __syncthreads();
    const XcdBarrier xb = xcd_barrier_post((unsigned*)(P0.ws + OFF_RSS), xbst);
#ifndef EXTRA_SYNCS
#define EXTRA_SYNCS 0
#endif
    for (int es = 0; es < EXTRA_SYNCS; ++es) { asm volatile("s_waitcnt vmcnt(0)" ::: "memory"); grid.sync(); }
#pragma unroll 1
    for (int pc = ph_lo; pc < ph_hi; ++pc) {
#if DUP_PHASE >= 0
        const int ph = pc > DUP_PHASE ? pc - 1 : pc;
#else
        const int ph = pc;
#endif
        int kind, arg = 0;
        switch (ph) {
            case 0: kind = 0; break;
            case 1: kind = 1; arg = 0; break;
            case 2: kind = 2; arg = 0; break;
            case 3: kind = 4; break;
            case 4: kind = 5; break;
            case 5: kind = 7; break;
            case 6: kind = 8; break;
            case 7: kind = 9; break;
            case 8: kind = 10; break;
            case 9: kind = 1; arg = 1; break;
            case 10: kind = 2; arg = 1; break;
            case 11: kind = 1; arg = 2; break;
            case 12: kind = 2; arg = 2; break;
            case 13: kind = 11; break;
            case 14: kind = 12; break;
            case 15: kind = 13; break;
            case 16: kind = 1; arg = 3; break;
            default: kind = 2; arg = 3; break;
        }
        int tid = threadIdx.x, bid = __builtin_amdgcn_readfirstlane((int)BLK_ID);
        asm volatile("" : "+v"(tid), "+s"(bid));
        Params P = P0;
        asm volatile("" : "+s"(P.ws), "+s"(P.out));
        unsigned char* ws = P.ws;
        float* X = (float*)(ws + OFF_X);
        bf16_t* H = (bf16_t*)(ws + OFF_H);
        bf16_t* GU = (bf16_t*)(ws + OFF_GU);
        float* RSS = (float*)(ws + OFF_SPARE);
        bf16_t* HALT = (bf16_t*)P.out;
        if (ph >= 100) { phase_tap(P, ph - 100, tid, bid); continue; }
        if (EN(0) && kind == 0) phase_init(P, L, tid, bid);
        else if (EN(1) && kind == 1) { EpiGU E; E.O = GU; E.rss = RSS; E.rsb = (LAS float*)(L + 131072); consumer_gemm(P, L, (arg & 1) ? HALT : H, (const bf16_t*)(ws + OFF_WGU + (size_t)arg * SZ_WGU), 5632, 1024, E, 1, arg == 1 ? 3 : (arg == 2 ? 1 : 4), tid, bid, arg != 0, arg == 1 ? 1 : (arg == 2 ? 0 : 2)); }
        else if (EN(2) && kind == 2) { EpiAddX E; E.X = X; E.scale = 0.5f; E.out = P.out; E.final_ = (arg == 3) ? 1 : 0; E.xb = H; E.rss = RSS; run_gemm(L, GU, (const bf16_t*)(ws + OFF_WD + (size_t)arg * SZ_WD), MAIN_ROWS, 1024, 2816, E, tid, bid); }
        else if (EN(3) && kind == 3) {
            const float* g = arg == 0 ? P.in[16] : (arg == 1 ? P.in[12] : (arg == 2 ? P.in[8] + 1024 : (arg == 3 ? P.in[16] + 1024 : P.in[12] + 1024)));
            phase_norm(P, g, tid, bid);
        }
        else if (EN(4) && kind == 4) { EpiBf16 E; E.O = GU; E.ldc = HINW; E.rss = RSS; E.rsb = (LAS float*)(L + 131072); consumer_gemm(P, L, H, (const bf16_t*)(ws + OFF_WIN), 2816, 1024, E, 0, 0, tid, bid); }
        else if (EN(5) && kind == 5) {
#ifndef GDN_SKIP
#define GDN_SKIP 0
#endif
#ifndef G1_SKIPM
#define G1_SKIPM 0
#endif
            const bool dup_run = DUP_PHASE >= 0 && pc == DUP_PHASE + 1;
            if (bid < 64) { if (!(dup_run && (GDN_SKIP & 1))) { int t2 = tid, b2 = bid; asm volatile("" : "+v"(t2), "+s"(b2)); phase_scan(P, L, t2, b2); } }
            else { if (!(dup_run && (GDN_SKIP & 2))) { int t2 = tid, b2 = bid; asm volatile("" : "+v"(t2), "+s"(b2)); phase_g1(P, L, t2, b2, dup_run ? G1_SKIPM : 0);
                    convert_group(P, L, t2, 1, b2 - 64, (int)gridDim.x - 64); convert_group(P, L, t2, 2, b2 - 64, (int)gridDim.x - 64); convert_group(P, L, t2, 3, b2 - 64, (int)gridDim.x - 64); } }
        }
        else if (EN(7) && kind == 7) phase_mlaprep(P, tid, bid);
        else if (EN(8) && kind == 8) {
            if (K8SUB & 1) { EpiQ E; E.Q = (bf16_t*)(ws + OFF_Q); E.qn = P.in[27]; E.qr = P.in[28]; E.rope = (const float2*)(ws + OFF_ROPE); E.scale = 0.10206207261596577f * 1.4426950408889634f;
              run_gemm(L, (const bf16_t*)(ws + OFF_CQ), (const bf16_t*)(ws + OFF_WUQ), MP, 768, 384, E, tid, bid); }
            if (K8SUB & 2) { EpiKN E; E.KN = (bf16_t*)(ws + OFF_KN); E.kn = P.in[29];
              run_gemm(L, (const bf16_t*)(ws + OFF_CKVA), (const bf16_t*)(ws + OFF_WUKVK), MKP, 512, 256, E, tid, bid); }
            if (K8SUB & 4) { EpiBf16 E; E.O = (bf16_t*)(ws + OFF_VT); E.ldc = MKP; E.rss = nullptr; E.rsb = (LAS float*)(L + 131072);
              run_gemm(L, (const bf16_t*)(ws + OFF_WUKVV), (const bf16_t*)(ws + OFF_CKVA), 512, MKP, 256, E, tid, bid); }
        }
        else if (EN(9) && kind == 9) phase_attn(P, L, tid, bid);
        else if (EN(10) && kind == 10) { EpiAddX E; E.X = X; E.scale = 1.0f; E.out = P.out; E.final_ = 0; E.xb = HALT; E.rss = RSS; run_gemm(L, H, (const bf16_t*)(ws + OFF_WOUT), MAIN_ROWS, 1024, 1024, E, tid, bid); }
        else if (EN(11) && kind == 11) { EpiSC E; E.Pb = (bf16_t*)(ws + OFF_P); E.BG = (bf16_t*)(ws + OFF_BG); E.rss = RSS; E.rsb = (LAS float*)(L + 131072); consumer_gemm(P, L, H, (const bf16_t*)(ws + OFF_WSCIN), 3072, 1024, E, 2, 2, tid, bid); }
        else if (EN(12) && kind == 12) phase_sconv(P, tid, bid);
        else if (EN(13)) { EpiAddX E; E.X = X; E.scale = 1.0f; E.out = P.out; E.final_ = 0; E.xb = HALT; E.rss = RSS; run_gemm(L, H, (const bf16_t*)(ws + OFF_WSCOUT), MAIN_ROWS, 1024, 1024, E, tid, bid); }
        if (pc + 1 < ph_hi) {
            if (ph_hi > 4096) { asm volatile("s_waitcnt vmcnt(0)" ::: "memory"); grid.sync(); }
            else xcd_barrier(xb);
        }
    }
}

extern "C" void kernel_launch(void* const* d_in, const int* in_sizes, int n_in, void* d_out, int out_size, void* d_ws, size_t ws_size, hipStream_t stream) {
    static int grid_blocks = 0;
    if (grid_blocks == 0) {
        if (n_in != 34 || ws_size < WS_NEED) { fprintf(stderr, "kernel_launch: unexpected n_in %d / ws_size %zu (need %zu)\n", n_in, ws_size, (size_t)WS_NEED); grid_blocks = -1; return; }
        int dev = 0, cus = 0, per_cu = 0;
        (void)hipGetDevice(&dev);
        (void)hipDeviceGetAttribute(&cus, hipDeviceAttributeMultiprocessorCount, dev);
        if (hipFuncSetAttribute((const void*)mega, hipFuncAttributeMaxDynamicSharedMemorySize, LDS_BYTES) != hipSuccess) { fprintf(stderr, "kernel_launch: hipFuncSetAttribute failed\n"); grid_blocks = -1; return; }
        if (hipOccupancyMaxActiveBlocksPerMultiprocessor(&per_cu, (const void*)mega, 512, LDS_BYTES) != hipSuccess || per_cu < 1) { fprintf(stderr, "kernel_launch: occupancy query gave %d\n", per_cu); per_cu = 1; }
        (void)hipGetLastError();
        grid_blocks = cus * per_cu;
    }
    if (grid_blocks < 0) return;
    (void)hipMemsetAsync((unsigned char*)d_ws + OFF_RSS, 0, 20480, stream);
    Params p{};
    for (int i = 0; i < 34; ++i) p.in[i] = (const float*)d_in[i];
    p.out = (float*)d_out; p.ws = (unsigned char*)d_ws;
#ifndef MULTI_LAUNCH
#define MULTI_LAUNCH 0
#endif
#if MULTI_LAUNCH
#ifndef STOP_AT
#define STOP_AT N_PHASES
#endif
    for (int ph = 0; ph < STOP_AT; ++ph) {
        int lo = ph, hi = ph + 1;
        void* args[] = {&p, &lo, &hi};
        hipError_t e = hipLaunchCooperativeKernel((const void*)mega, dim3(grid_blocks), dim3(512), args, LDS_BYTES, stream);
        if (e != hipSuccess) { fprintf(stderr, "launch %d failed: %s (grid %d)\n", ph, hipGetErrorString(e), grid_blocks); break; }
    }
#ifdef TAP
    { int lo = 100 + TAP, hi = 101 + TAP; void* args[] = {&p, &lo, &hi};
      (void)hipLaunchCooperativeKernel((const void*)mega, dim3(grid_blocks), dim3(512), args, LDS_BYTES, stream); }
#endif
#else
    int lo = 0, hi = N_PHASES + (DUP_PHASE >= 0 ? 1 : 0);
    void* args[] = {&p, &lo, &hi};
    hipError_t e = hipLaunchCooperativeKernel((const void*)mega, dim3(grid_blocks), dim3(512), args, LDS_BYTES, stream);
    if (e != hipSuccess) fprintf(stderr, "cooperative launch failed: %s (grid %d)\n", hipGetErrorString(e), grid_blocks);
#endif
}
```
